# Optimizing an MI355X kernel written in HIP

```python
import jax, jax.numpy as jnp
from jax import lax
import numpy as np

D_MODEL = 2048
BATCH = 8
SEQ = 2048
DEPTH = 2

N_MIXERS = 2
MEM_LEN = 256
EPS = 1e-6

MIX_WIDTH = D_MODEL
TOK_WIDTH = 3 * D_MODEL // 4
XA_HEADS = 4
XA_HEAD_DIM = D_MODEL // 16
XA_WIDTH = XA_HEADS * XA_HEAD_DIM

POOL_WINDOWS = (2, 4, 8, 16)
N_POOL_GROUPS = 4
POOL_GROUP_WIDTH = TOK_WIDTH // N_POOL_GROUPS

HEAD_DIM = 64
N_Q_HEADS = TOK_WIDTH // HEAD_DIM
GQA_RATIO = 8
N_KV_HEADS = N_Q_HEADS // GQA_RATIO
KV_WIDTH = N_KV_HEADS * HEAD_DIM
ATTN_IN_WIDTH = TOK_WIDTH + 2 * KV_WIDTH + XA_WIDTH
WINDOW = 128
BLOCK = 128
ROPE_THETA = 500000.0
ROT_DIM = HEAD_DIM // 4
NEG_INF = -1e30

N_EXPERTS = 16
CAPACITY_FACTOR = 2
D_EXPERT = D_MODEL // 2

kernel_name = "interleaved_pool_swa_memxattn_ecmoe_encoder"


def rmsnorm(x, g):
    x32 = x.astype(jnp.float32)
    y = x32 * lax.rsqrt(jnp.mean(x32 * x32, axis=-1, keepdims=True) + EPS)
    return (y * g.astype(jnp.float32)).astype(x.dtype)


def partial_rotary(t, positions):
    rot, keep = t[..., :ROT_DIM], t[..., ROT_DIM:]
    inv_freq = ROPE_THETA ** (-jnp.arange(0, ROT_DIM, 2, dtype=jnp.float32) / ROT_DIM)
    ang = positions.astype(jnp.float32)[..., None] * inv_freq
    cos = jnp.cos(ang)[:, :, None, :]
    sin = jnp.sin(ang)[:, :, None, :]
    r = rot.astype(jnp.float32)
    r1, r2 = r[..., : ROT_DIM // 2], r[..., ROT_DIM // 2:]
    out = jnp.concatenate([r1 * cos - r2 * sin, r2 * cos + r1 * sin], axis=-1)
    return jnp.concatenate([out.astype(t.dtype), keep], axis=-1)


def multiscale_pool(u, w_group, scale):
    B, S, _ = u.shape
    u32 = u.astype(jnp.float32)
    cs = jnp.concatenate([jnp.zeros((B, 1, TOK_WIDTH), jnp.float32), jnp.cumsum(u32, axis=1)], axis=1)
    t = np.arange(S)
    outs = []
    for g, w in enumerate(POOL_WINDOWS):
        lo = np.maximum(t - w // 2, 0)
        hi = np.minimum(t + w // 2 - 1, S - 1)
        cnt = jnp.asarray((hi - lo + 1).astype(np.float32))[None, :, None]
        sl = slice(g * POOL_GROUP_WIDTH, (g + 1) * POOL_GROUP_WIDTH)
        csg = cs[:, :, sl]
        mean = (csg[:, hi + 1] - csg[:, lo]) / cnt
        outs.append(mean - u32[:, :, sl])
    pooled = jnp.stack(outs, axis=2).astype(u.dtype)
    mixed = jnp.einsum('bsgc,gcd->bsgd', pooled, w_group)
    return mixed.reshape(B, S, TOK_WIDTH) * scale


def window_gqa_sink(q, k, v, sink):
    B, S = q.shape[0], q.shape[1]
    nb = S // BLOCK
    qb = q.reshape(B, nb, BLOCK, N_KV_HEADS, GQA_RATIO, HEAD_DIM)
    pad = ((0, 0), (BLOCK, BLOCK), (0, 0), (0, 0))
    kp = jnp.pad(k, pad).reshape(B, nb + 2, BLOCK, N_KV_HEADS, HEAD_DIM)
    vp = jnp.pad(v, pad).reshape(B, nb + 2, BLOCK, N_KV_HEADS, HEAD_DIM)
    kb = jnp.concatenate([kp[:, :-2], kp[:, 1:-1], kp[:, 2:]], axis=2)
    vb = jnp.concatenate([vp[:, :-2], vp[:, 1:-1], vp[:, 2:]], axis=2)
    blk = np.arange(nb)[:, None, None] * BLOCK
    qpos = blk + np.arange(BLOCK)[None, :, None]
    kpos = blk - BLOCK + np.arange(3 * BLOCK)[None, None, :]
    valid = jnp.asarray((np.abs(kpos - qpos) <= WINDOW) & (kpos >= 0) & (kpos < S))
    scores = jnp.einsum('bnqhgd,bnkhd->bnhgqk', qb, kb).astype(jnp.float32) * (HEAD_DIM ** -0.5)
    scores = jnp.where(valid[None, :, None, None], scores, NEG_INF)
    s = sink.astype(jnp.float32).reshape(N_KV_HEADS, GQA_RATIO)[None, None, :, :, None, None]
    m = jnp.maximum(jnp.max(scores, axis=-1, keepdims=True), s)
    p = jnp.exp(scores - m)
    probs = p / (jnp.sum(p, axis=-1, keepdims=True) + jnp.exp(s - m))
    out = jnp.einsum('bnhgqk,bnkhd->bnqhgd', probs.astype(v.dtype), vb)
    return out.reshape(B, S, N_Q_HEADS * HEAD_DIM)


def memory_cross_attention(qx, mem_kv):
    B, S, _ = qx.shape
    q = qx.reshape(B, S, XA_HEADS, XA_HEAD_DIM)
    k = mem_kv[..., :XA_WIDTH].reshape(B, -1, XA_HEADS, XA_HEAD_DIM)
    v = mem_kv[..., XA_WIDTH:].reshape(B, -1, XA_HEADS, XA_HEAD_DIM)
    scores = jnp.einsum('bshd,bmhd->bhsm', q, k).astype(jnp.float32) * (XA_HEAD_DIM ** -0.5)
    probs = jax.nn.softmax(scores, axis=-1).astype(v.dtype)
    return jnp.einsum('bhsm,bmhd->bshd', probs, v).reshape(B, S, XA_WIDTH)


def expert_choice_ffn(h, w_router, w_gate, w_up, w_down):
    B, S, _ = h.shape
    cap = CAPACITY_FACTOR * S // N_EXPERTS
    aff = jax.nn.softmax(jnp.einsum('bsd,de->bse', h, w_router).astype(jnp.float32), axis=-1)
    gates, idx = lax.top_k(jnp.swapaxes(aff, 1, 2), cap)
    bidx = jnp.arange(B)[:, None, None]
    xg = h[bidx, idx]
    a = jnp.einsum('becd,edf->becf', xg, w_gate)
    u = jnp.einsum('becd,edf->becf', xg, w_up)
    y = jnp.einsum('becf,efd->becd', jax.nn.silu(a) * u, w_down) * gates[..., None].astype(h.dtype)
    return jnp.zeros_like(h).at[bidx, idx].add(y)


def setup_inputs(seed: int = 0) -> dict:
    key = jax.random.key(seed)
    ks = jax.random.split(key, 24)
    n_pool = (DEPTH + 1) // 2
    n_attn = DEPTH // 2
    f32 = jnp.float32

    def w(k, shape, fan_in):
        return jax.random.normal(k, shape, f32) * (fan_in ** -0.5)

    def gain(k, shape):
        return 1.0 + 0.05 * jax.random.normal(k, shape, f32)

    x = jax.random.normal(ks[0], (BATCH, SEQ, D_MODEL), f32)
    mem = jax.random.normal(ks[1], (BATCH, MEM_LEN, D_MODEL), f32)
    offset = jax.random.randint(ks[2], (BATCH, 1), 0, 4096, dtype=jnp.int32)
    positions = offset + jnp.arange(SEQ, dtype=jnp.int32)[None, :]
    return {
        "x": x,
        "mem": mem,
        "positions": positions,
        "norm_mix_g": gain(ks[3], (DEPTH, D_MODEL)),
        "norm_ffn_g": gain(ks[4], (DEPTH, D_MODEL)),
        "mem_norm_g": gain(ks[5], (D_MODEL,)),
        "final_g": gain(ks[6], (D_MODEL,)),
        "mem_w_kv": w(ks[7], (DEPTH, D_MODEL, 2 * XA_WIDTH), D_MODEL),
        "pool_w_in": w(ks[8], (n_pool, D_MODEL, MIX_WIDTH), D_MODEL),
        "pool_group_w": w(ks[9], (n_pool, N_POOL_GROUPS, POOL_GROUP_WIDTH, POOL_GROUP_WIDTH), POOL_GROUP_WIDTH),
        "pool_scale": gain(ks[10], (n_pool, TOK_WIDTH)),
        "pool_w_out": w(ks[11], (n_pool, MIX_WIDTH, D_MODEL), MIX_WIDTH),
        "attn_w_in": w(ks[12], (n_attn, D_MODEL, ATTN_IN_WIDTH), D_MODEL),
        "attn_sink": 0.5 * jax.random.normal(ks[13], (n_attn, N_Q_HEADS), f32),
        "attn_w_out": w(ks[14], (n_attn, MIX_WIDTH, D_MODEL), MIX_WIDTH),
        "router_w": w(ks[15], (DEPTH, D_MODEL, N_EXPERTS), D_MODEL),
        "exp_w_gate": w(ks[16], (DEPTH, N_EXPERTS, D_MODEL, D_EXPERT), D_MODEL),
        "exp_w_up": w(ks[17], (DEPTH, N_EXPERTS, D_MODEL, D_EXPERT), D_MODEL),
        "exp_w_down": w(ks[18], (DEPTH, N_EXPERTS, D_EXPERT, D_MODEL), D_EXPERT),
    }


def reference(x, mem, positions, norm_mix_g, norm_ffn_g, mem_norm_g, final_g, mem_w_kv,
              pool_w_in, pool_group_w, pool_scale, pool_w_out,
              attn_w_in, attn_sink, attn_w_out,
              router_w, exp_w_gate, exp_w_up, exp_w_down):
    B, S, _ = x.shape
    mem_n = rmsnorm(mem, mem_norm_g)
    for layer in range(DEPTH):
        h = rmsnorm(x, norm_mix_g[layer])
        mem_kv = jnp.einsum('bmd,de->bme', mem_n, mem_w_kv[layer])
        j = layer // N_MIXERS
        if layer % N_MIXERS == 0:
            proj = jnp.einsum('bsd,de->bse', h, pool_w_in[j])
            tok = multiscale_pool(proj[..., :TOK_WIDTH], pool_group_w[j], pool_scale[j])
            mem_out = memory_cross_attention(proj[..., TOK_WIDTH:], mem_kv)
            w_out = pool_w_out[j]
        else:
            proj = jnp.einsum('bsd,de->bse', h, attn_w_in[j])
            o1 = TOK_WIDTH
            o2 = o1 + KV_WIDTH
            o3 = o2 + KV_WIDTH
            q = partial_rotary(proj[..., :o1].reshape(B, S, N_Q_HEADS, HEAD_DIM), positions)
            k = partial_rotary(proj[..., o1:o2].reshape(B, S, N_KV_HEADS, HEAD_DIM), positions)
            v = proj[..., o2:o3].reshape(B, S, N_KV_HEADS, HEAD_DIM)
            tok = window_gqa_sink(q, k, v, attn_sink[j])
            mem_out = memory_cross_attention(proj[..., o3:], mem_kv)
            w_out = attn_w_out[j]
        x = x + jnp.einsum('bse,ed->bsd', jnp.concatenate([tok, mem_out], axis=-1), w_out)
        h = rmsnorm(x, norm_ffn_g[layer])
        x = x + expert_choice_ffn(h, router_w[layer], exp_w_gate[layer], exp_w_up[layer], exp_w_down[layer])
    return rmsnorm(x, final_g)
```

```cpp
#include <hip/hip_runtime.h>
#include <cstdio>
#include <cstdint>

#ifndef MK_PER_PHASE
#define MK_PER_PHASE 0
#endif

#define LAS __attribute__((address_space(3)))
#define GAS __attribute__((address_space(1)))
typedef unsigned short bf16_t;
typedef short bf16x8 __attribute__((ext_vector_type(8)));
typedef short s16x4 __attribute__((ext_vector_type(4)));
typedef float f32x2 __attribute__((ext_vector_type(2)));
typedef float f32x4 __attribute__((ext_vector_type(4)));
typedef float f32x16 __attribute__((ext_vector_type(16)));
typedef unsigned u32x2 __attribute__((ext_vector_type(2)));
typedef unsigned u32x4 __attribute__((ext_vector_type(4)));
typedef __bf16 bf16x2_t __attribute__((ext_vector_type(2)));
typedef GAS unsigned gu32;

constexpr int NB = 8, SEQ = 2048, DM = 2048, M = NB * SEQ, MEML = 256, MR = NB * MEML;
constexpr int TOK = 1536, XAW = 512, KVW = 192, AIN = 2432, AINP = 2560;
constexpr int NE = 16, CAP = 256, DE = 1024, ER = NB * CAP;
constexpr float EPS = 1e-6f;
constexpr float LOG2E = 1.4426950408889634f;

constexpr size_t MiB = 1u << 20;
constexpr size_t WS_CTL = 0, CTL_ZERO_BYTES = 64 * 1024;
constexpr size_t WS_WMEMKV = 1 * MiB;
constexpr size_t WS_WPIN = 9 * MiB;
constexpr size_t WS_WPOUT = 17 * MiB;
constexpr size_t WS_WGRP = 25 * MiB;
constexpr size_t WS_WAIN = 27 * MiB;
constexpr size_t WS_WAOUT = 37 * MiB;
constexpr size_t WS_WGU = 45 * MiB;
constexpr size_t WS_XN8 = 173 * MiB;
constexpr size_t WS_WDN = 301 * MiB;
constexpr size_t WS_XN = 429 * MiB;
constexpr size_t WS_MEMN = 493 * MiB;
constexpr size_t WS_MEMKV = 501 * MiB;
constexpr size_t WS_PROJ = 509 * MiB;
constexpr size_t WS_WPOUT2 = 589 * MiB;
constexpr size_t WS_CAT = 637 * MiB;
constexpr size_t WS_HACT = 701 * MiB;
constexpr size_t WS_Y = 765 * MiB;
constexpr size_t WS_AFFT = 893 * MiB;
constexpr size_t WS_IDX = 894 * MiB;
constexpr size_t WS_WRT = 894 * MiB + 256 * 1024;
constexpr size_t WS_RINV = 894 * MiB + 768 * 1024;
constexpr size_t WS_SEL = 895 * MiB;
constexpr size_t WS_ROPE = 896 * MiB;
constexpr size_t WS_XB = 897 * MiB;
constexpr size_t WS_END = 961 * MiB;
constexpr int CW_BAR = 4096;

constexpr int RING_BYTES = 143360;
constexpr int TAB_OFF = RING_BYTES;
constexpr int MISC_OFF = TAB_OFF + 8192;
constexpr int LDS_BYTES = MISC_OFF + 256;
constexpr int NWAVES = 8, NTHR = 512;

#define LDS_WAIT() asm volatile("s_waitcnt lgkmcnt(0)" ::: "memory")
#define VM_WAIT() asm volatile("s_waitcnt vmcnt(0)" ::: "memory")
__device__ __forceinline__ float bf2f(bf16_t v) { return __uint_as_float(((unsigned)v) << 16); }
__device__ __forceinline__ unsigned pk2(float lo, float hi) { f32x2 v = {lo, hi}; bf16x2_t b = __builtin_convertvector(v, bf16x2_t); return __builtin_bit_cast(unsigned, b); }
__device__ __forceinline__ bf16_t f2bf(float f) { return (bf16_t)(pk2(f, 0.f) & 0xffffu); }
__device__ __forceinline__ float lo16(unsigned w) { return __uint_as_float(w << 16); }
__device__ __forceinline__ float hi16(unsigned w) { return __uint_as_float(w & 0xffff0000u); }
constexpr float Y_SCALE = 32.0f, Y_INV = 1.0f / 32.0f;
constexpr float SC_CAT = 16.0f, SC_WD8 = 64.0f;
__device__ __forceinline__ unsigned pk4_fp8(float a, float b, float c, float d) {
    a = __builtin_amdgcn_fmed3f(a, -448.f, 448.f); b = __builtin_amdgcn_fmed3f(b, -448.f, 448.f); c = __builtin_amdgcn_fmed3f(c, -448.f, 448.f); d = __builtin_amdgcn_fmed3f(d, -448.f, 448.f);
    int w = __builtin_amdgcn_cvt_pk_fp8_f32(a, b, 0, false); w = __builtin_amdgcn_cvt_pk_fp8_f32(c, d, w, true); return (unsigned)w;
}
__device__ __forceinline__ f32x4 up4_fp8(unsigned w) { const f32x2 lo = __builtin_amdgcn_cvt_pk_f32_fp8((int)w, false), hi = __builtin_amdgcn_cvt_pk_f32_fp8((int)w, true); return (f32x4){lo.x, lo.y, hi.x, hi.y}; }
__device__ __forceinline__ float wave_sum(float v) {
#pragma unroll
    for (int o = 1; o < 64; o <<= 1) v += __shfl_xor(v, o);
    return v;
}
__device__ __forceinline__ int crow(int r, int hi) { return (r & 3) + 8 * (r >> 2) + 4 * hi; }

#define XB_TMO      128
#define XB_XCNT(j)  (256  + 64 * (j))
#define XB_XSUB(j)  (1280 + 64 * (j))
#define XB_XGEN(j)  (2304 + 64 * (j))
#define XB_TOP      3328
#define XB_TOPGEN   3392
#define XCD_BAR_WORDS 3456
#define XB_SPIN_CAP (1u << 18)
__device__ __forceinline__ unsigned xb_ld(unsigned* p)              { return __hip_atomic_load(p, __ATOMIC_RELAXED, __HIP_MEMORY_SCOPE_AGENT); }
__device__ __forceinline__ unsigned xb_add(unsigned* p, unsigned v) { return __hip_atomic_fetch_add(p, v, __ATOMIC_RELAXED, __HIP_MEMORY_SCOPE_AGENT); }
__device__ __forceinline__ unsigned xb_xcc_id() { return (unsigned)__builtin_amdgcn_s_getreg((3 << 11) | 20) & 0xFu; }
#define XB_SPIN(cond, bar) do { unsigned _sp = 0; while (cond) { __builtin_amdgcn_s_sleep(1); \
    if ((++_sp & 255u) == 0u) { if (xb_ld(&(bar)[XB_TMO])) break; if (_sp > XB_SPIN_CAP) { atomicAdd(&(bar)[XB_TMO], 1u); break; } } } } while (0)
struct XcdBarrier { unsigned* bar; unsigned x; volatile LAS unsigned* st; };
__device__ __forceinline__ XcdBarrier xcd_barrier_post(unsigned* bar, volatile LAS unsigned* st) {
    XcdBarrier b; b.bar = bar; b.x = xb_xcc_id(); b.st = st;
    if (threadIdx.x == 0) (void)xb_add(&bar[XB_XCNT(b.x)], 1u);
    return b;
}
__device__ __forceinline__ void xcd_barrier_complete(unsigned* bar, unsigned x, unsigned& nloc, unsigned& nx) {
    const unsigned G = gridDim.x * gridDim.y * gridDim.z;
    unsigned sum, cnt, mine, sp = 0u;
    for (;;) {
        sum = 0u; cnt = 0u; mine = 0u;
#pragma unroll
        for (unsigned j = 0; j < 16; ++j) { const unsigned c = xb_ld(&bar[XB_XCNT(j)]); sum += c; cnt += (c > 0u) ? 1u : 0u; mine = (j == x) ? c : mine; }
        if (sum == G) break;
        __builtin_amdgcn_s_sleep(1);
        if ((++sp & 255u) == 0u) { if (xb_ld(&bar[XB_TMO])) break; if (sp > XB_SPIN_CAP) { atomicAdd(&bar[XB_TMO], 1u); break; } }
    }
    nloc = mine > 0u ? mine : 1u; nx = cnt > 0u ? cnt : 1u;
}
__device__ __forceinline__ void xcd_barrier(const XcdBarrier& b) {
    asm volatile("s_waitcnt vmcnt(0)" ::: "memory");
    __syncthreads();
    if (threadIdx.x == 0) {
        unsigned* bar = b.bar;
        __builtin_amdgcn_s_waitcnt(0);
        unsigned nloc = b.st[0], nx = b.st[1];
        if (nloc == 0u) { xcd_barrier_complete(bar, b.x, nloc, nx); b.st[0] = nloc; b.st[1] = nx; }
        const unsigned old = xb_add(&bar[XB_XSUB(b.x)], 1u);
        const unsigned gen = old / nloc;
        if (old + 1u == (gen + 1u) * nloc) {
            __builtin_amdgcn_fence(__ATOMIC_RELEASE, "agent");
            asm volatile("s_waitcnt vmcnt(0)" ::: "memory");
            const unsigned og = xb_add(&bar[XB_TOP], 1u);
            const unsigned tg = og / nx;
            if (og + 1u == (tg + 1u) * nx) xb_add(&bar[XB_TOPGEN], 1u);
            else XB_SPIN(xb_ld(&bar[XB_TOPGEN]) == tg, bar);
            __builtin_amdgcn_fence(__ATOMIC_ACQUIRE, "agent");
            xb_add(&bar[XB_XGEN(b.x)], 1u);
            asm volatile("s_waitcnt vmcnt(0)" ::: "memory");
        } else {
            XB_SPIN(xb_ld(&bar[XB_XGEN(b.x)]) == gen, bar);
            __builtin_amdgcn_fence(__ATOMIC_ACQUIRE, "agent");
            asm volatile("s_waitcnt vmcnt(0)" ::: "memory");
        }
    }
    __syncthreads();
}

#define XB_LCNT(j)  (4096 + 64 * (j))
#define XB_BAD      6144
__device__ __forceinline__ void xcd_local_barrier(const XcdBarrier& b, unsigned target) {
    asm volatile("s_waitcnt vmcnt(0)" ::: "memory");
    __syncthreads();
    if (threadIdx.x == 0) {
        unsigned* bar = b.bar;
        __builtin_amdgcn_s_waitcnt(0);
        (void)xb_add(&bar[XB_LCNT(b.x)], 1u);
        XB_SPIN(xb_ld(&bar[XB_LCNT(b.x)]) < target, bar);
        __builtin_amdgcn_fence(__ATOMIC_ACQUIRE, "agent");
        asm volatile("s_waitcnt vmcnt(0)" ::: "memory");
    }
    __syncthreads();
}

namespace pg8 {
constexpr int BM = 256, BK = 64, HALF = 128, HTB = HALF * BK * 2;
__device__ __forceinline__ int lds_byte(int r, int c) { const int st = (r >> 4) * 2 + (c >> 5), rr = r & 15, cc = c & 31, ob = rr * 64 + cc * 2; return st * 1024 + (ob ^ (((ob >> 9) & 1) << 5)); }
__device__ __forceinline__ void stage_rc(int b, int& R, int& C) { const int st = b / 1024, sb = b % 1024, swz = sb ^ (((sb >> 9) & 1) << 5); R = (st >> 1) * 16 + swz / 64; C = (st & 1) * 32 + (swz % 64) / 2; }
__device__ __forceinline__ int perm32(int rho) { const int n = rho >> 4, i = rho & 15; return 8 * (i >> 2) + 4 * n + (i & 3); }
struct Unit { int pm, pn, e; };
typedef int i32x8 __attribute__((ext_vector_type(8)));
typedef int i32x4 __attribute__((ext_vector_type(4)));
__device__ __forceinline__ i32x8 cat8(bf16x8 a, bf16x8 b) { const i32x4 x = __builtin_bit_cast(i32x4, a), y = __builtin_bit_cast(i32x4, b); return (i32x8){x[0], x[1], x[2], x[3], y[0], y[1], y[2], y[3]}; }
typedef f32x4 Acc[2][2][4][2];
__device__ __forceinline__ void xcd_tile(int L, int nM, int nN, int& pm, int& pn) {
    const int nwg = nM * nN; int wgid = L; { const int q = nwg / 8, r = nwg % 8, xcd = wgid % 8, off = wgid / 8; wgid = (xcd < r ? xcd * (q + 1) : r * (q + 1) + (xcd - r) * q) + off; }
    const int nig = 8 * nN, gid = wgid / nig, fm = gid * 8, gsz = (nM - fm) < 8 ? (nM - fm) : 8;
    pm = fm + ((wgid % nig) % gsz); pn = (wgid % nig) / gsz;
}

template <class P>
__device__ __forceinline__ void gemm_phase(LAS unsigned char* lds, LAS int* tab, const P& p) {
    const int tid = threadIdx.x, wid = __builtin_amdgcn_readfirstlane(tid >> 6), lane = tid & 63, wr = wid >> 2, wc = wid & 3, fr = lane & 15, fq = lane >> 4;
    const int nt = p.nt;
    Unit cur, nxt; int ui = 0;
    if (!p.next(0, cur)) return;
    if constexpr (P::GATHER) { Unit tu; for (int i = 0; p.next(i, tu); ++i) p.fill_tab(tab, i, tu, tid); LDS_WAIT(); __syncthreads(); }
    int R_[2], C_[2]; unsigned voffB[2];
#pragma unroll
    for (int i = 0; i < 2; ++i) { int R, C; stage_rc(tid * 16 + i * 8192, R, C); R_[i] = R; C_[i] = C; const int Rb = P::PERM ? ((R & ~31) + perm32(R & 31)) : R; voffB[i] = (unsigned)(Rb * p.ldb) * (unsigned)P::ESZ + (unsigned)C * 2u; }
    unsigned voffA0[2], voffA1[2];
#define PG8_SETA(U, UI) do { if constexpr (P::GATHER_A) { _Pragma("unroll") for (int _i = 0; _i < 2; ++_i) { voffA0[_i] = p.a_rowoff(U, UI, R_[_i], tab) + (unsigned)C_[_i] * 2u; voffA1[_i] = p.a_rowoff(U, UI, R_[_i] + HALF, tab) + (unsigned)C_[_i] * 2u; } } } while (0)
    if constexpr (P::GATHER_A) { PG8_SETA(cur, 0); }
    else { _Pragma("unroll") for (int _i = 0; _i < 2; ++_i) { voffA0[_i] = p.a_rowoff(cur, 0, R_[_i], tab) + (unsigned)C_[_i] * 2u; voffA1[_i] = voffA0[_i]; } }
    const size_t hstepA = P::GATHER_A ? (size_t)0 : (size_t)p.a_rowoff(cur, 0, HALF, tab);
    const size_t kstep = (size_t)(BK * 2), hstepB = (size_t)HALF * p.ldb * P::ESZ;
    const unsigned ldsw = (unsigned)wid * 1024u;
    const int aoff = lds_byte(wr * 64 + fr, fq * 8), boff = lds_byte(wc * 32 + fr, fq * 8);
#define PG8_SA(b, h) (((b) * 2 + (h)) * HTB)
#define PG8_SB(b, h) ((4 + (b) * 2 + (h)) * HTB)
#define PG8_STAGE(bufoff, gbase, voff) do { _Pragma("unroll") for (int _i = 0; _i < 2; ++_i) \
        __builtin_amdgcn_global_load_lds((const unsigned*)((const char*)(gbase) + (voff)[_i]), (LAS unsigned*)(lds + (bufoff) + ldsw + _i * 8192), 16, 0, 0); } while (0)
#define PG8_LDA(dst, b, h) do { _Pragma("unroll") for (int m = 0; m < 4; ++m) _Pragma("unroll") for (int k = 0; k < 2; ++k) dst[m][k] = *(const LAS bf16x8*)(lds + PG8_SA(b, h) + aoff + m * 2048 + k * 1024); } while (0)
#define PG8_LDB(dst, b, h) do { _Pragma("unroll") for (int n = 0; n < 2; ++n) _Pragma("unroll") for (int k = 0; k < 2; ++k) dst[n][k] = *(const LAS bf16x8*)(lds + PG8_SB(b, h) + boff + n * 2048 + k * 1024); } while (0)
#define PG8_MMA(ai, bj, At, Bt) do { __builtin_amdgcn_s_setprio(1); \
        if constexpr (P::ESZ == 2) { _Pragma("unroll") for (int m = 0; m < 4; ++m) _Pragma("unroll") for (int n = 0; n < 2; ++n) _Pragma("unroll") for (int k = 0; k < 2; ++k) \
            acc[ai][bj][m][n] = __builtin_amdgcn_mfma_f32_16x16x32_bf16(Bt[n][k], At[m][k], acc[ai][bj][m][n], 0, 0, 0); } \
        else { _Pragma("unroll") for (int m = 0; m < 4; ++m) _Pragma("unroll") for (int n = 0; n < 2; ++n) \
            acc[ai][bj][m][n] = __builtin_amdgcn_mfma_scale_f32_16x16x128_f8f6f4(cat8(Bt[n][0], Bt[n][1]), cat8(At[m][0], At[m][1]), acc[ai][bj][m][n], 0, 0, 0, 0x7F7F7F7F, 0, 0x7F7F7F7F); } \
        __builtin_amdgcn_s_setprio(0); } while (0)
#define PG8_WAIT_V(n) asm volatile("s_waitcnt vmcnt(" #n ")" ::: "memory")
#define PG8_WAIT_L(n) asm volatile("s_waitcnt lgkmcnt(" #n ")" ::: "memory")
#define PG8_BAR __builtin_amdgcn_s_barrier()
#define PG8_SCHED __builtin_amdgcn_sched_barrier(0)
    Acc acc;
#pragma unroll
    for (int a = 0; a < 2; ++a)
#pragma unroll
        for (int b = 0; b < 2; ++b)
#pragma unroll
            for (int m = 0; m < 4; ++m)
#pragma unroll
                for (int n = 0; n < 2; ++n) acc[a][b][m][n] = (f32x4){0.f, 0.f, 0.f, 0.f};
    bf16x8 At[4][2], B0[2][2], B1[2][2];
    const char* cA = p.a_base(cur); const char* cB = p.b_base(cur);
    PG8_STAGE(PG8_SB(0, 0), cB, voffB); PG8_STAGE(PG8_SB(0, 1), cB + hstepB, voffB); PG8_STAGE(PG8_SA(0, 0), cA, voffA0); PG8_STAGE(PG8_SA(0, 1), cA + hstepA, voffA1);
    if (wr == 1) PG8_BAR;
    PG8_WAIT_V(2); PG8_BAR;
    PG8_STAGE(PG8_SB(1, 0), cB + kstep, voffB); PG8_STAGE(PG8_SA(1, 0), cA + kstep, voffA0); PG8_STAGE(PG8_SB(1, 1), cB + hstepB + kstep, voffB);
    PG8_WAIT_V(6); PG8_BAR;
    for (;;) {
        const bool has_next = p.next(ui + 1, nxt);
        const char* nA = has_next ? p.a_base(nxt) : cA; const char* nB = has_next ? p.b_base(nxt) : cB;
#pragma unroll 1
        for (int t = 0; t < nt; t += 2) {
            const bool last = (t == nt - 2);
            const char* a1 = cA + (size_t)(t + 1) * kstep;
            const char* a2 = last ? nA : cA + (size_t)(t + 2) * kstep; const char* b2 = last ? nB : cB + (size_t)(t + 2) * kstep;
            const char* a3 = a2 + kstep; const char* b3 = b2 + kstep;
            PG8_LDB(B0, 0, 0); PG8_LDB(B1, 0, 1); PG8_SCHED; PG8_LDA(At, 0, 0); PG8_STAGE(PG8_SA(1, 1), a1 + hstepA, voffA1);
            if (last && has_next) { PG8_SETA(nxt, ui + 1); }
            PG8_WAIT_V(8); PG8_WAIT_L(0); PG8_BAR; PG8_MMA(0, 0, At, B0); PG8_MMA(0, 1, At, B1); PG8_BAR; PG8_SCHED;
            PG8_LDA(At, 0, 1); PG8_STAGE(PG8_SB(0, 0), b2, voffB); PG8_STAGE(PG8_SB(0, 1), b2 + hstepB, voffB); PG8_STAGE(PG8_SA(0, 0), a2, voffA0);
            PG8_WAIT_V(8); PG8_WAIT_L(0); PG8_BAR; PG8_MMA(1, 0, At, B0); PG8_MMA(1, 1, At, B1); PG8_BAR; PG8_SCHED;
            PG8_LDB(B0, 1, 0); PG8_LDB(B1, 1, 1); PG8_SCHED; PG8_LDA(At, 1, 0); PG8_STAGE(PG8_SA(0, 1), a2 + hstepA, voffA1);
            PG8_WAIT_V(8); PG8_WAIT_L(0); PG8_BAR; PG8_MMA(0, 0, At, B0); PG8_MMA(0, 1, At, B1); PG8_BAR; PG8_SCHED;
            PG8_LDA(At, 1, 1); PG8_STAGE(PG8_SB(1, 0), b3, voffB); PG8_STAGE(PG8_SB(1, 1), b3 + hstepB, voffB); PG8_STAGE(PG8_SA(1, 0), a3, voffA0);
            PG8_WAIT_V(8); PG8_WAIT_L(0); PG8_BAR; PG8_MMA(1, 0, At, B0); PG8_MMA(1, 1, At, B1); PG8_BAR; PG8_SCHED;
        }
        if (wr == 0) PG8_BAR;
        { int fr_ = fr, fq_ = fq; asm volatile("" : "+v"(fr_), "+v"(fq_));
          p.epi(acc, cur, ui, tab, wr, wc, fr_, fq_); }
        if (!has_next) break;
#pragma unroll
        for (int a = 0; a < 2; ++a)
#pragma unroll
            for (int b = 0; b < 2; ++b)
#pragma unroll
                for (int m = 0; m < 4; ++m)
#pragma unroll
                    for (int n = 0; n < 2; ++n) acc[a][b][m][n] = (f32x4){0.f, 0.f, 0.f, 0.f};
        cur = nxt; cA = nA; cB = nB; ++ui;
        if (wr == 1) PG8_BAR;
    }
    PG8_WAIT_V(0);
    PG8_BAR;
#undef PG8_SETA
#undef PG8_SA
#undef PG8_SB
#undef PG8_STAGE
#undef PG8_LDA
#undef PG8_LDB
#undef PG8_MMA
#undef PG8_WAIT_V
#undef PG8_WAIT_L
#undef PG8_BAR
#undef PG8_SCHED
}

struct ProbDense8 {
    static constexpr bool PERM = true, GATHER = false, GATHER_A = true; static constexpr int ESZ = 1;
    const unsigned char* A; const unsigned char* Bt; bf16_t* O; int nM, nN, ldo;
    const unsigned char* A2; const unsigned char* Bt2; bf16_t* O2; int nM2, nN2, ldo2;
    int nt, lda, ldb, G, c;
    __device__ __forceinline__ bool next(int i, Unit& u) const {
        if (c < 0) return false;
        int L = i * G + c; const int n1 = nM * nN;
        if (L < n1) { xcd_tile(L, nM, nN, u.pm, u.pn); u.e = 0; return true; }
        L -= n1; if (L >= nM2 * nN2) return false;
        xcd_tile(L, nM2, nN2, u.pm, u.pn); u.e = 1; return true;
    }
    __device__ __forceinline__ const char* a_base(const Unit& u) const { return (const char*)(u.e ? A2 : A); }
    __device__ __forceinline__ const char* b_base(const Unit& u) const { return (const char*)(u.e ? Bt2 : Bt) + (size_t)u.pn * BM * ldb; }
    __device__ __forceinline__ unsigned a_rowoff(const Unit& u, int, int r, LAS int*) const { return (unsigned)((u.pm * BM + r) * lda); }
    __device__ __forceinline__ void fill_tab(LAS int*, int, const Unit&, int) const {}
    __device__ __forceinline__ void epi(const Acc& acc, const Unit& u, int, LAS int*, int wr, int wc, int fr, int fq) const {
        bf16_t* o = u.e ? O2 : O; const int ld = u.e ? ldo2 : ldo;
        const int row0 = u.pm * BM + wr * 64 + fr, col0 = u.pn * BM + wc * 32 + 8 * fq;
        constexpr float inv = 1.0f / (8.0f * 64.0f);
#pragma unroll
        for (int ai = 0; ai < 2; ++ai)
#pragma unroll
            for (int m = 0; m < 4; ++m) { bf16_t* rowp = o + (size_t)(row0 + ai * HALF + m * 16) * ld + col0;
#pragma unroll
                for (int bj = 0; bj < 2; ++bj) { const f32x4 v0 = acc[ai][bj][m][0] * inv, v1 = acc[ai][bj][m][1] * inv;
                    u32x4 w; w.x = pk2(v0[0], v0[1]); w.y = pk2(v0[2], v0[3]); w.z = pk2(v1[0], v1[1]); w.w = pk2(v1[2], v1[3]);
                    *(u32x4*)(rowp + bj * HALF) = w; } }
    }
};
struct ProbDense {
    static constexpr bool PERM = true, GATHER = false, GATHER_A = false; static constexpr int ESZ = 2;
    const bf16_t* A; const bf16_t* Bt; bf16_t* O; int nM, nN, ldo;
    const bf16_t* A2; const bf16_t* Bt2; bf16_t* O2; int nM2, nN2, ldo2;
    int nt, lda, ldb, G, c;
    __device__ __forceinline__ bool next(int i, Unit& u) const {
        if (c < 0) return false;
        int L = i * G + c; const int n1 = nM * nN;
        if (L < n1) { xcd_tile(L, nM, nN, u.pm, u.pn); u.e = 0; return true; }
        L -= n1; if (L >= nM2 * nN2) return false;
        xcd_tile(L, nM2, nN2, u.pm, u.pn); u.e = 1; return true;
    }
    __device__ __forceinline__ const char* a_base(const Unit& u) const { return (const char*)(u.e ? A2 : A) + (size_t)u.pm * BM * lda * 2; }
    __device__ __forceinline__ const char* b_base(const Unit& u) const { return (const char*)(u.e ? Bt2 : Bt) + (size_t)u.pn * BM * ldb * 2; }
    __device__ __forceinline__ unsigned a_rowoff(const Unit&, int, int r, LAS int*) const { return (unsigned)(r * lda) * 2u; }
    __device__ __forceinline__ void fill_tab(LAS int*, int, const Unit&, int) const {}
    __device__ __forceinline__ void epi(const Acc& acc, const Unit& u, int, LAS int*, int wr, int wc, int fr, int fq) const {
        bf16_t* o = u.e ? O2 : O; const int ld = u.e ? ldo2 : ldo;
        const int row0 = u.pm * BM + wr * 64 + fr, col0 = u.pn * BM + wc * 32 + 8 * fq;
#pragma unroll
        for (int ai = 0; ai < 2; ++ai)
#pragma unroll
            for (int m = 0; m < 4; ++m) { bf16_t* rowp = o + (size_t)(row0 + ai * HALF + m * 16) * ld + col0;
#pragma unroll
                for (int bj = 0; bj < 2; ++bj) { const f32x4 v0 = acc[ai][bj][m][0], v1 = acc[ai][bj][m][1];
                    u32x4 w; w.x = pk2(v0[0], v0[1]); w.y = pk2(v0[2], v0[3]); w.z = pk2(v1[0], v1[1]); w.w = pk2(v1[2], v1[3]);
                    *(u32x4*)(rowp + bj * HALF) = w; } }
    }
};
template <bool RF32>
struct ProbOut {
    static constexpr bool PERM = true, GATHER = false, GATHER_A = false; static constexpr int ESZ = 2;
    const bf16_t* A; const bf16_t* Bt; const void* R; bf16_t* X; const float* RS; const float* Gn;
    int nt, lda, ldb, G, c;
    __device__ __forceinline__ bool next(int i, Unit& u) const { const int L = i * G + c; if (L >= 64 * 8) return false; xcd_tile(L, 64, 8, u.pm, u.pn); u.e = 0; return true; }
    __device__ __forceinline__ const char* a_base(const Unit& u) const { return (const char*)A + (size_t)u.pm * BM * lda * 2; }
    __device__ __forceinline__ const char* b_base(const Unit& u) const { return (const char*)Bt + (size_t)u.pn * BM * ldb * 2; }
    __device__ __forceinline__ unsigned a_rowoff(const Unit&, int, int r, LAS int*) const { return (unsigned)(r * lda) * 2u; }
    __device__ __forceinline__ void fill_tab(LAS int*, int, const Unit&, int) const {}
    __device__ __forceinline__ void epi(const Acc& acc, const Unit& u, int, LAS int*, int wr, int wc, int fr, int fq) const {
        const int row0 = u.pm * BM + wr * 64 + fr, col0 = u.pn * BM + wc * 32 + 8 * fq;
        f32x4 gi[2][2];
        if constexpr (RF32) {
#pragma unroll
            for (int bj = 0; bj < 2; ++bj)
#pragma unroll
                for (int q = 0; q < 2; ++q) { const f32x4 gv = *(const f32x4*)(Gn + col0 + bj * HALF + 4 * q); gi[bj][q] = (f32x4){1.0f / gv.x, 1.0f / gv.y, 1.0f / gv.z, 1.0f / gv.w}; }
        }
#pragma unroll
        for (int ai = 0; ai < 2; ++ai) {
            if constexpr (RF32) {
                u32x4 rv[4][2]; float rs[4];
#pragma unroll
                for (int m = 0; m < 4; ++m) { const bf16_t* rp = (const bf16_t*)R + (size_t)(row0 + ai * HALF + m * 16) * DM + col0; rs[m] = RS[row0 + ai * HALF + m * 16];
#pragma unroll
                    for (int bj = 0; bj < 2; ++bj) rv[m][bj] = *(const u32x4*)(rp + bj * HALF); }
                asm volatile("" ::: "memory");
#pragma unroll
                for (int m = 0; m < 4; ++m) { bf16_t* xp = X + (size_t)(row0 + ai * HALF + m * 16) * DM + col0;
#pragma unroll
                    for (int bj = 0; bj < 2; ++bj) { const u32x4 r = rv[m][bj]; const f32x4 q0 = gi[bj][0] * rs[m], q1 = gi[bj][1] * rs[m];
                        const f32x4 v0 = (f32x4){lo16(r.x), hi16(r.x), lo16(r.y), hi16(r.y)} * q0 + acc[ai][bj][m][0], v1 = (f32x4){lo16(r.z), hi16(r.z), lo16(r.w), hi16(r.w)} * q1 + acc[ai][bj][m][1];
                        u32x4 w; w.x = pk2(v0[0], v0[1]); w.y = pk2(v0[2], v0[3]); w.z = pk2(v1[0], v1[1]); w.w = pk2(v1[2], v1[3]);
                        *(u32x4*)(xp + bj * HALF) = w; } }
            } else {
                u32x4 rv[4][2];
#pragma unroll
                for (int m = 0; m < 4; ++m) { const bf16_t* rp = (const bf16_t*)R + (size_t)(row0 + ai * HALF + m * 16) * DM + col0;
#pragma unroll
                    for (int bj = 0; bj < 2; ++bj) rv[m][bj] = *(const u32x4*)(rp + bj * HALF); }
                asm volatile("" ::: "memory");
#pragma unroll
                for (int m = 0; m < 4; ++m) { bf16_t* xp = X + (size_t)(row0 + ai * HALF + m * 16) * DM + col0;
#pragma unroll
                    for (int bj = 0; bj < 2; ++bj) { const f32x4 a0 = acc[ai][bj][m][0], a1 = acc[ai][bj][m][1]; const u32x4 r = rv[m][bj];
                        u32x4 w; w.x = pk2(lo16(r.x) + a0[0], hi16(r.x) + a0[1]); w.y = pk2(lo16(r.y) + a0[2], hi16(r.y) + a0[3]);
                        w.z = pk2(lo16(r.z) + a1[0], hi16(r.z) + a1[1]); w.w = pk2(lo16(r.w) + a1[2], hi16(r.w) + a1[3]);
                        *(u32x4*)(xp + bj * HALF) = w; } }
            }
            asm volatile("" ::: "memory");
        }
    }
};
struct ProbOut8 {
    static constexpr bool PERM = true, GATHER = false, GATHER_A = true; static constexpr int ESZ = 1;
    const unsigned char* A; const unsigned char* Bt; bf16_t* X;
    int nt, lda, ldb, G, c;
    __device__ __forceinline__ bool next(int i, Unit& u) const { const int L = i * G + c; if (L >= 64 * 8) return false; xcd_tile(L, 64, 8, u.pm, u.pn); u.e = 0; return true; }
    __device__ __forceinline__ const char* a_base(const Unit&) const { return (const char*)A; }
    __device__ __forceinline__ const char* b_base(const Unit& u) const { return (const char*)Bt + (size_t)u.pn * BM * ldb; }
    __device__ __forceinline__ unsigned a_rowoff(const Unit& u, int, int r, LAS int*) const { return (unsigned)((u.pm * BM + r) * lda); }
    __device__ __forceinline__ void fill_tab(LAS int*, int, const Unit&, int) const {}
    __device__ __forceinline__ void epi(const Acc& acc, const Unit& u, int, LAS int*, int wr, int wc, int fr, int fq) const {
        const int row0 = u.pm * BM + wr * 64 + fr, col0 = u.pn * BM + wc * 32 + 8 * fq;
        constexpr float inv = 1.0f / (16.0f * 64.0f);
#pragma unroll
        for (int ai = 0; ai < 2; ++ai) {
            u32x4 rv[4][2];
#pragma unroll
            for (int m = 0; m < 4; ++m) { const bf16_t* rp = X + (size_t)(row0 + ai * HALF + m * 16) * DM + col0;
#pragma unroll
                for (int bj = 0; bj < 2; ++bj) rv[m][bj] = *(const u32x4*)(rp + bj * HALF); }
            asm volatile("" ::: "memory");
#pragma unroll
            for (int m = 0; m < 4; ++m) { bf16_t* xp = X + (size_t)(row0 + ai * HALF + m * 16) * DM + col0;
#pragma unroll
                for (int bj = 0; bj < 2; ++bj) { const f32x4 a0 = acc[ai][bj][m][0] * inv, a1 = acc[ai][bj][m][1] * inv; const u32x4 r = rv[m][bj];
                    u32x4 w; w.x = pk2(lo16(r.x) + a0[0], hi16(r.x) + a0[1]); w.y = pk2(lo16(r.y) + a0[2], hi16(r.y) + a0[3]);
                    w.z = pk2(lo16(r.z) + a1[0], hi16(r.z) + a1[1]); w.w = pk2(lo16(r.w) + a1[2], hi16(r.w) + a1[3]);
                    *(u32x4*)(xp + bj * HALF) = w; } }
            asm volatile("" ::: "memory");
        }
    }
};
struct ProbFold {
    static constexpr bool PERM = true, GATHER = false, GATHER_A = false; static constexpr int ESZ = 2;
    const bf16_t* A; const bf16_t* Bt; bf16_t* O;
    int nt, lda, ldb, G, c;
    __device__ __forceinline__ bool next(int i, Unit& u) const { if (i != 0 || c < 0 || c >= 64) return false; u.pm = c & 7; u.e = c >> 3; u.pn = 0; return true; }
    __device__ __forceinline__ const char* a_base(const Unit& u) const { return (const char*)A + ((size_t)u.pm * BM * lda + (size_t)(u.e >> 1) * 384) * 2; }
    __device__ __forceinline__ const char* b_base(const Unit& u) const { return (const char*)Bt + (size_t)u.e * BM * ldb * 2; }
    __device__ __forceinline__ unsigned a_rowoff(const Unit&, int, int r, LAS int*) const { return (unsigned)(r * lda) * 2u; }
    __device__ __forceinline__ void fill_tab(LAS int*, int, const Unit&, int) const {}
    __device__ __forceinline__ void epi(const Acc& acc, const Unit& u, int, LAS int*, int wr, int wc, int fr, int fq) const {
        const int g = u.e >> 1, hh = u.e & 1;
        const int row0 = u.pm * BM + wr * 64 + fr;
#pragma unroll
        for (int bj = 0; bj < 2; ++bj) {
            if (hh && bj) continue;
            const int col = g * 384 + hh * 256 + bj * HALF + wc * 32 + 8 * fq;
#pragma unroll
            for (int ai = 0; ai < 2; ++ai)
#pragma unroll
                for (int m = 0; m < 4; ++m) { const f32x4 v0 = acc[ai][bj][m][0], v1 = acc[ai][bj][m][1];
                    u32x4 w; w.x = pk2(v0[0], v0[1]); w.y = pk2(v0[2], v0[3]); w.z = pk2(v1[0], v1[1]); w.w = pk2(v1[2], v1[3]);
                    *(u32x4*)(O + (size_t)(row0 + ai * HALF + m * 16) * DM + col) = w; }
        }
    }
};
__device__ __forceinline__ float silu_f(float g) { return g * __builtin_amdgcn_rcpf(1.0f + __builtin_amdgcn_exp2f(-g * LOG2E)); }
constexpr float SC_X = 8.0f, SC_WGU = 64.0f, SC_H = 16.0f, SC_WDN = 32.0f;
struct ProbGU {
    static constexpr bool PERM = true, GATHER = true, GATHER_A = true; static constexpr int ESZ = 1;
    const unsigned char* A; const unsigned char* Bt; const int* IDX; bf16_t* O;
    int nt, lda, ldb, G, c;
    __device__ __forceinline__ bool next(int i, Unit& u) const { const int L = i * G + c; if (L >= 1024) return false; const int wg = (L % 8) * 128 + L / 8; u.e = wg / 64; const int w = wg % 64; u.pm = w % 8; u.pn = w / 8; return true; }
    __device__ __forceinline__ const char* a_base(const Unit&) const { return (const char*)A; }
    __device__ __forceinline__ const char* b_base(const Unit& u) const { return (const char*)Bt + (size_t)(u.e * 8 + u.pn) * BM * ldb; }
    __device__ __forceinline__ unsigned a_rowoff(const Unit&, int ui, int r, LAS int* tab) const { return (unsigned)tab[ui * 256 + r] * (unsigned)DM; }
    __device__ __forceinline__ void fill_tab(LAS int* tab, int ui, const Unit& u, int tid) const { if (tid < 256 && ui < 8) tab[ui * 256 + tid] = IDX[(u.e * 8 + u.pm) * 256 + tid]; }
    __device__ __forceinline__ void epi(const Acc& acc, const Unit& u, int, LAS int*, int wr, int wc, int fr, int fq) const {
        const int row0 = u.e * ER + u.pm * BM + wr * 64 + fr, col0 = u.pn * HALF + wc * 32 + 8 * fq;
        constexpr float inv = 1.0f / (SC_X * SC_WGU);
#pragma unroll
        for (int ai = 0; ai < 2; ++ai)
#pragma unroll
            for (int m = 0; m < 4; ++m) { const f32x4 g0 = acc[ai][0][m][0] * inv, g1 = acc[ai][0][m][1] * inv, u0 = acc[ai][1][m][0] * (inv * SC_H), u1 = acc[ai][1][m][1] * (inv * SC_H);
                u32x2 w; w.x = pk4_fp8(silu_f(g0[0]) * u0[0], silu_f(g0[1]) * u0[1], silu_f(g0[2]) * u0[2], silu_f(g0[3]) * u0[3]);
                w.y = pk4_fp8(silu_f(g1[0]) * u1[0], silu_f(g1[1]) * u1[1], silu_f(g1[2]) * u1[2], silu_f(g1[3]) * u1[3]);
                *(u32x2*)((unsigned char*)O + (size_t)(row0 + ai * HALF + m * 16) * DE + col0) = w; }
    }
};
struct ProbDN {
    static constexpr bool PERM = true, GATHER = true, GATHER_A = true; static constexpr int ESZ = 1;
    const bf16_t* A; const bf16_t* Bt; const float* GATE; bf16_t* O;
    int nt, lda, ldb, G, c;
    __device__ __forceinline__ bool next(int i, Unit& u) const { const int L = i * G + c; if (L >= 1024) return false; const int wg = (L % 8) * 128 + L / 8; u.e = wg / 64; const int w = wg % 64; u.pm = w % 8; u.pn = w / 8; return true; }
    __device__ __forceinline__ const char* a_base(const Unit&) const { return (const char*)A; }
    __device__ __forceinline__ const char* b_base(const Unit& u) const { return (const char*)Bt + (size_t)(u.e * DM + u.pn * BM) * ldb; }
    __device__ __forceinline__ unsigned a_rowoff(const Unit& u, int, int r, LAS int*) const { return (unsigned)((u.e * ER + u.pm * BM + r) * lda); }
    __device__ __forceinline__ void fill_tab(LAS int* tab, int ui, const Unit& u, int tid) const { if (tid < 256 && ui < 8) ((LAS float*)tab)[ui * 256 + tid] = GATE[(u.e * 8 + u.pm) * 256 + tid]; }
    __device__ __forceinline__ void epi(const Acc& acc, const Unit& u, int ui, LAS int* tab, int wr, int wc, int fr, int fq) const {
        const int r0 = wr * 64 + fr, pos0 = u.pn * BM + wc * 64 + 16 * fq;
        const LAS float* gp = (const LAS float*)tab + ui * 256;
#pragma unroll
        for (int ai = 0; ai < 2; ++ai)
#pragma unroll
            for (int m = 0; m < 4; ++m) { const int r = r0 + ai * HALF + m * 16; const float gt = gp[r] * (Y_SCALE / (SC_H * SC_WDN));
                const f32x4 a0 = acc[ai][0][m][0] * gt, a1 = acc[ai][0][m][1] * gt, b0 = acc[ai][1][m][0] * gt, b1 = acc[ai][1][m][1] * gt;
                u32x4 w; w.x = pk4_fp8(a0[0], a0[1], a0[2], a0[3]); w.y = pk4_fp8(a1[0], a1[1], a1[2], a1[3]); w.z = pk4_fp8(b0[0], b0[1], b0[2], b0[3]); w.w = pk4_fp8(b1[0], b1[1], b1[2], b1[3]);
                *(u32x4*)((unsigned char*)O + (size_t)(u.e * ER + u.pm * BM + r) * DM + pos0) = w; }
    }
};
}

struct Ctx {
    LAS unsigned char* lds; int tid, lane, wave, G, gw, NGW;
    int rb, rs, re;
    unsigned char* ws; gu32* ctl;
};
#define WSP(T, off) ((T*)(C.ws + (off)))

struct TItem { const float* src; bf16_t* dst; int ldw, ldt; };
__device__ __forceinline__ TItem titem(const float* W, int ldw, int k0, int n0, bf16_t* WT, int ldt, int drow0, int lane) {
    const int kg = lane >> 3, ng = lane & 7;
    TItem t; t.src = W + (size_t)(k0 + 8 * kg) * ldw + n0 + 4 * ng; t.dst = WT + (size_t)(drow0 + n0 + 4 * ng) * ldt + k0 + 8 * kg; t.ldw = ldw; t.ldt = ldt; return t;
}
__device__ __forceinline__ void titem_load(const TItem& t, f32x4 (&v)[8]) {
#pragma unroll
    for (int r = 0; r < 8; ++r) v[r] = __builtin_nontemporal_load((const f32x4*)(t.src + (size_t)r * t.ldw));
}
__device__ __forceinline__ void titem_store(const TItem& t, const f32x4 (&v)[8]) {
#pragma unroll
    for (int q = 0; q < 4; ++q) { u32x4 o; o.x = pk2(v[0][q], v[1][q]); o.y = pk2(v[2][q], v[3][q]); o.z = pk2(v[4][q], v[5][q]); o.w = pk2(v[6][q], v[7][q]);
        __builtin_nontemporal_store(o, (u32x4*)(t.dst + (size_t)q * t.ldt)); }
}
__device__ __forceinline__ void transpose_item(const float* W, int ldw, int k0, int n0, bf16_t* WT, int ldt, int drow0, LAS float*, int lane) {
    const TItem t = titem(W, ldw, k0, n0, WT, ldt, drow0, lane); f32x4 v[8]; titem_load(t, v); titem_store(t, v);
}
__device__ __forceinline__ void rms_rows_bf16(const float* X, const float* g, bf16_t* O, float* RS, int first, int stride, int nrows, int lane) {
    if (first >= nrows) return;
    f32x4 gq[4][2], xn[4][2];
#pragma unroll
    for (int j = 0; j < 4; ++j)
#pragma unroll
        for (int q = 0; q < 2; ++q) { gq[j][q] = *(const f32x4*)(g + 8 * lane + 512 * j + 4 * q); xn[j][q] = __builtin_nontemporal_load((const f32x4*)(X + (size_t)first * DM + 8 * lane + 512 * j + 4 * q)); }
    for (int m = first; m < nrows; m += stride) {
        f32x4 v[4][2]; float ss = 0.f;
#pragma unroll
        for (int j = 0; j < 4; ++j)
#pragma unroll
            for (int q = 0; q < 2; ++q) { v[j][q] = xn[j][q]; ss += (v[j][q].x * v[j][q].x + v[j][q].y * v[j][q].y) + (v[j][q].z * v[j][q].z + v[j][q].w * v[j][q].w); }
        const int mn = (m + stride < nrows) ? m + stride : m;
#pragma unroll
        for (int j = 0; j < 4; ++j)
#pragma unroll
            for (int q = 0; q < 2; ++q) xn[j][q] = __builtin_nontemporal_load((const f32x4*)(X + (size_t)mn * DM + 8 * lane + 512 * j + 4 * q));
        const float r = 1.0f / sqrtf(wave_sum(ss) * (1.0f / DM) + EPS);
        if (RS != nullptr && lane == 0) RS[m] = 1.0f / r;
#pragma unroll
        for (int j = 0; j < 4; ++j) { const f32x4 a = v[j][0] * r * gq[j][0], b = v[j][1] * r * gq[j][1];
            u32x4 o; o.x = pk2(a.x, a.y); o.y = pk2(a.z, a.w); o.z = pk2(b.x, b.y); o.w = pk2(b.z, b.w);
            *(u32x4*)(O + (size_t)m * DM + 8 * lane + 512 * j) = o; }
    }
}
constexpr int IT_LE = 1024, IT_EXP = 2 * NE * IT_LE;
constexpr int CONV1_N = 256, CONV1_ITEMS = 64 * CONV1_N;
constexpr int CONV2_WG = 96, CONV2_N = 170, SLOT2_ITEMS = CONV2_WG * CONV2_N;
constexpr int DN10_N = 0, DN10_ITEMS = CONV2_WG * DN10_N;
static_assert(NE * 512 - DN10_ITEMS <= 4 * 2048, "P11 hides one down-weight item per wave in each of its 3 window-attention units and 1 cross-attention unit");
constexpr int IT_MOVED = CONV1_ITEMS + SLOT2_ITEMS, SLOT1_ITEMS = CONV1_ITEMS;
static_assert(SLOT2_ITEMS <= IT_EXP / 2 && IT_MOVED <= IT_EXP, "P10's items are layer-1 items (needed from P15 on); P1's may be of either layer (needed from P7 on)");
struct TItem8 { const float* src; unsigned char* dst; int ldw, ldt; float sc; };
__device__ __forceinline__ TItem8 expert_titem(int r, const float* w_gate, const float* w_up, const float*, unsigned char* ws, int lane) {
    const int le = r / IT_LE, rr = r % IT_LE, kind = rr >> 9, q = rr & 511, kg = lane >> 3, ng = lane & 7;
    const int kb = q >> 5, nb = q & 31, n0 = 32 * nb, k0 = 128 * kb;
    TItem8 t;
    t.src = (kind ? w_up : w_gate) + (size_t)le * DM * DE + (size_t)(k0 + 16 * kg) * DE + n0 + 4 * ng; t.ldw = DE;
    t.dst = ws + WS_WGU + (size_t)le * DM * DM + (size_t)((n0 >> 7) * 256 + kind * 128 + (n0 & 127) + 4 * ng) * DM + k0 + 16 * kg; t.ldt = DM; t.sc = pg8::SC_WGU;
    return t;
}
__device__ __forceinline__ void titem8_load(const TItem8& t, f32x4 (&v)[16]) {
#pragma unroll
    for (int r = 0; r < 16; ++r) v[r] = __builtin_nontemporal_load((const f32x4*)(t.src + (size_t)r * t.ldw));
}
__device__ __forceinline__ void titem8_load_seq(const TItem8& t, f32x4 (&v)[16]) {
    const float* p = t.src;
#pragma unroll
    for (int r = 0; r < 16; ++r) { v[r] = __builtin_nontemporal_load((const f32x4*)p); p += t.ldw; asm volatile("" : "+v"(p)); }
}
__device__ __forceinline__ void titem8_store(const TItem8& t, const f32x4 (&v)[16]) {
#pragma unroll
    for (int q = 0; q < 4; ++q) { u32x4 o;
        o.x = pk4_fp8(v[0][q] * t.sc, v[1][q] * t.sc, v[2][q] * t.sc, v[3][q] * t.sc); o.y = pk4_fp8(v[4][q] * t.sc, v[5][q] * t.sc, v[6][q] * t.sc, v[7][q] * t.sc);
        o.z = pk4_fp8(v[8][q] * t.sc, v[9][q] * t.sc, v[10][q] * t.sc, v[11][q] * t.sc); o.w = pk4_fp8(v[12][q] * t.sc, v[13][q] * t.sc, v[14][q] * t.sc, v[15][q] * t.sc);
        __builtin_nontemporal_store(o, (u32x4*)(t.dst + (size_t)q * t.ldt)); }
}
__device__ __forceinline__ void titem8_load_half(const TItem8& t, int half, f32x4 (&v)[8]) {
    const float* p = t.src + (size_t)(8 * half) * t.ldw;
#pragma unroll
    for (int r = 0; r < 8; ++r) { v[r] = __builtin_nontemporal_load((const f32x4*)p); p += t.ldw; asm volatile("" : "+v"(p)); }
}
__device__ __forceinline__ void titem8_store_half(const TItem8& t, int half, const f32x4 (&v)[8]) {
#pragma unroll
    for (int q = 0; q < 4; ++q) { u32x2 o;
        o.x = pk4_fp8(v[0][q] * t.sc, v[1][q] * t.sc, v[2][q] * t.sc, v[3][q] * t.sc); o.y = pk4_fp8(v[4][q] * t.sc, v[5][q] * t.sc, v[6][q] * t.sc, v[7][q] * t.sc);
        __builtin_nontemporal_store(o, (u32x2*)(t.dst + (size_t)q * t.ldt + 8 * half)); }
}
__device__ __forceinline__ void expert_items(int first, int stride, int end, const float* w_gate, const float* w_up, const float* w_down, unsigned char* ws, int lane) {
    int r = first;
    for (; r + stride < end; r += 2 * stride) {
        const TItem8 t0 = expert_titem(r, w_gate, w_up, w_down, ws, lane), t1 = expert_titem(r + stride, w_gate, w_up, w_down, ws, lane);
        f32x4 v0[16], v1[16]; titem8_load(t0, v0); titem8_load(t1, v1);
        titem8_store(t0, v0); titem8_store(t1, v1);
    }
    for (; r < end; r += stride) { const TItem8 t = expert_titem(r, w_gate, w_up, w_down, ws, lane); f32x4 v[16]; titem8_load(t, v); titem8_store(t, v); }
}
__device__ __forceinline__ TItem8 down_titem(int rr, const float* w_down, unsigned char* ws, int lane) {
    const int le = rr >> 9, q = rr & 511, kb = q >> 6, nb = q & 63, kg = lane >> 3, ng = lane & 7;
    TItem8 t; t.src = w_down + (size_t)le * DE * DM + (size_t)(128 * kb + 16 * kg) * DM + 32 * nb + 4 * ng; t.ldw = DM;
    t.dst = ws + WS_WDN + (size_t)le * DM * DE + (size_t)(32 * nb + 4 * ng) * DE + 128 * kb + 16 * kg; t.ldt = DE; t.sc = pg8::SC_WDN; return t;
}
__device__ __forceinline__ void down_items(int first, int stride, int end, const float* w_down, unsigned char* ws, int lane) {
    for (int r = first; r < end; r += 2 * stride) {
        TItem8 t[2];
#pragma unroll
        for (int i = 0; i < 2; ++i) { const int rr = (r + i * stride < end) ? r + i * stride : r, le = rr >> 9, q = rr & 511, kb = q >> 6, nb = q & 63, kg = lane >> 3, ng = lane & 7;
            t[i].src = w_down + (size_t)le * DE * DM + (size_t)(128 * kb + 16 * kg) * DM + 32 * nb + 4 * ng; t[i].ldw = DM;
            t[i].dst = ws + WS_WDN + (size_t)le * DM * DE + (size_t)(32 * nb + 4 * ng) * DE + 128 * kb + 16 * kg; t[i].ldt = DE; t[i].sc = pg8::SC_WDN; }
        f32x4 v0[16], v1[16]; titem8_load(t[0], v0); titem8_load(t[1], v1); titem8_store(t[0], v0); titem8_store(t[1], v1);
    }
}
__device__ __forceinline__ void expert_slot(const Ctx& C, int first, int n, const float* w_gate, const float* w_up, const float* w_down) {
    const int base = IT_EXP - IT_MOVED + first; expert_items(base + C.wave, NWAVES, base + n, w_gate, w_up, w_down, C.ws, C.lane);
}
__device__ __forceinline__ void w8_item(const float* W, int ldw, int k0, int n0, unsigned char* WT, int lane) {
    const int kg = lane >> 3, ng = lane & 7;
    TItem8 t; t.src = W + (size_t)(k0 + 16 * kg) * ldw + n0 + 4 * ng; t.ldw = ldw; t.dst = WT + (size_t)(n0 + 4 * ng) * DM + k0 + 16 * kg; t.ldt = DM; t.sc = 64.0f;
    f32x4 v[16]; titem8_load(t, v); titem8_store(t, v);
}
__device__ __forceinline__ void p0_prologue(const Ctx& C, const float* w_gate, const float* w_up, const float* w_down, const float* w_memkv, const float* w_pin, const float* w_pout, const float* w_aout, const float* w_ain, const float* w_grp,
                                            const float* x, const float* g_mix, const float* mem, const float* g_mem, const int* pos, const float* p_scale, const float* w_router) {
    LAS float* scr = (LAS float*)(C.lds + C.wave * 8448);
    constexpr int IT_NOW = IT_EXP - IT_MOVED;
    constexpr int IT_MKV = 2 * 1024, IT_PIN = 2048, IT_SQ = 2048, IT_AIN = 16 * 76, IT_AO8 = 1024, IT_GRP = 4 * 48;
    constexpr int NITEMS = IT_NOW + IT_MKV + IT_PIN + IT_SQ + IT_AO8 + IT_AIN + IT_GRP;
    expert_items(C.gw, C.NGW, IT_NOW, w_gate, w_up, w_down, C.ws, C.lane);
    for (int it = IT_NOW + C.gw; it < NITEMS; it += C.NGW) {
        int r = it - IT_NOW;
        if (r < IT_MKV) { const int l = r >> 10, q = r & 1023; transpose_item(w_memkv + (size_t)l * DM * 1024, 1024, 64 * (q >> 5), 32 * (q & 31), WSP(bf16_t, WS_WMEMKV) + (size_t)l * 1024 * DM, DM, 0, scr, C.lane); continue; }
        r -= IT_MKV;
        if (r < IT_PIN) { transpose_item(w_pin, DM, 64 * (r >> 6), 32 * (r & 63), WSP(bf16_t, WS_WPIN), DM, 0, scr, C.lane); continue; }
        r -= IT_PIN;
        if (r < IT_AIN) { w8_item(w_ain, AIN, 128 * (r / 76), 32 * (r % 76), WSP(unsigned char, WS_WAIN), C.lane); continue; }
        r -= IT_AIN;
        if (r < IT_SQ) { transpose_item(w_pout, DM, 64 * (r >> 6), 32 * (r & 63), WSP(bf16_t, WS_WPOUT), DM, 0, scr, C.lane);
            if (64 * (r >> 6) >= TOK) transpose_item(w_pout, DM, 64 * (r >> 6), 32 * (r & 63), WSP(bf16_t, WS_WPOUT2), DM, 0, scr, C.lane);
            continue; }
        r -= IT_SQ;
        if (r < IT_AO8) { w8_item(w_aout, DM, 128 * (r >> 6), 32 * (r & 63), WSP(unsigned char, WS_WAOUT), C.lane); continue; }
        r -= IT_AO8;
        {
            const int g = r / 48, c0 = (r % 48) * 8;
            for (int idx = C.lane; idx < 8 * 96; idx += 64) { const int cr = idx / 96, d4 = (idx % 96) * 4;
                const f32x4 w = *(const f32x4*)(w_grp + ((size_t)g * 384 + c0 + cr) * 384 + d4), sc = *(const f32x4*)(p_scale + g * 384 + d4);
                u32x2 o; o.x = pk2(w.x * sc.x, w.y * sc.y); o.y = pk2(w.z * sc.z, w.w * sc.w);
                *(u32x2*)(WSP(bf16_t, WS_WGRP) + ((size_t)g * 512 + c0 + cr) * 384 + d4) = o; } }
    }
    rms_rows_bf16(x, g_mix, WSP(bf16_t, WS_XN), WSP(float, WS_RINV), C.gw, C.NGW, M, C.lane);
    rms_rows_bf16(mem, g_mem, WSP(bf16_t, WS_MEMN), nullptr, C.gw, C.NGW, MR, C.lane);
    for (int idx = blockIdx.x * NTHR + C.tid; idx < 2 * NE * DM; idx += C.G * NTHR) {
        const int layer = idx / (NE * DM), e = (idx / DM) % NE, k = idx % DM;
        const float w = w_router[((size_t)layer * DM + k) * NE + e]; const bf16_t hi = f2bf(w); const bf16_t lo = f2bf(w - bf2f(hi));
        bf16_t* o = WSP(bf16_t, WS_WRT) + (size_t)layer * 2 * NE * DM + (size_t)e * DM + k; o[0] = hi; o[NE * DM] = lo;
    }
    for (int idx = blockIdx.x * NTHR + C.tid; idx < M * 8; idx += C.G * NTHR) {
        const int m = idx >> 3, i = idx & 7;
        const float invf = i == 0 ? 1.0f : i == 1 ? 0.1939227432012558f : i == 2 ? 0.03760603070259094f : i == 3 ? 0.007292664609849453f : i == 4 ? 0.0014142135623842478f : i == 5 ? 0.00027424818836152554f : i == 6 ? 5.3182957344688475e-05f : 1.0313385246263351e-05f;
        const float ang = (float)pos[m] * invf;
        const double a = (double)ang, k = __builtin_rint(a * 0.15915494309189535), rr = a - k * 6.283185307179586;
        const float rf = (float)rr;
        WSP(float, WS_ROPE)[idx] = cosf(rf); WSP(float, WS_ROPE + 512 * 1024)[idx] = sinf(rf);
    }
}

typedef short v4i16_t __attribute__((ext_vector_type(4)));
__device__ __forceinline__ s16x4 vtr(const LAS unsigned char* p) { return __builtin_bit_cast(s16x4, __builtin_amdgcn_ds_read_tr16_b64_v4i16((LAS v4i16_t*)p)); }
template <int DH, bool WIN, bool O8, int NIT>
__device__ __forceinline__ void attn_wave(const LAS unsigned char* KL, int kstr, const LAS unsigned char* VL, int vstr, const bf16x8 (&qf)[DH / 16],
                                          int koff, int kt_lo, int kt_hi, float m_run, float l_run, float cscale, bf16_t* obase, int ldo, LAS unsigned char* stg, int lane, int ditem, int dstep, const float* w_down, unsigned char* ws) {
    const int ql = lane & 31, h = lane >> 5;
    f32x16 o[DH / 32];
#pragma unroll
    for (int b = 0; b < DH / 32; ++b)
#pragma unroll
        for (int r = 0; r < 16; ++r) o[b][r] = 0.f;
    const LAS unsigned char* vbase = VL + (4 * h + ((lane & 15) >> 2)) * vstr + (16 * ((lane >> 4) & 1) + 4 * (lane & 3)) * 2;
    f32x4 dv[8];
    { int d0 = ditem; asm volatile("" : "+s"(d0)); const TItem8 dt = down_titem(d0, w_down, ws, lane); titem8_load_half(dt, 0, dv); }
    const int kt_q = (kt_hi - kt_lo) / (2 * NIT);
    for (int kt = kt_lo; kt < kt_hi; ++kt) {
#pragma unroll
        for (int hh = 1; hh < 2 * NIT; ++hh)
            if (kt == kt_lo + hh * kt_q) { int d1 = ditem + ((hh - 1) >> 1) * dstep, d2 = ditem + (hh >> 1) * dstep; asm volatile("" : "+s"(d1), "+s"(d2));
                const TItem8 dta = down_titem(d1, w_down, ws, lane), dtb = down_titem(d2, w_down, ws, lane); titem8_store_half(dta, (hh - 1) & 1, dv); titem8_load_half(dtb, hh & 1, dv); }
        f32x16 s;
#pragma unroll
        for (int r = 0; r < 16; ++r) s[r] = 0.f;
        const LAS unsigned char* kp = KL + ((kt + koff) * 32 + ql) * kstr + h * 16;
#pragma unroll
        for (int st = 0; st < DH / 16; ++st) { const bf16x8 kf = *(const LAS bf16x8*)(kp + st * 32); s = __builtin_amdgcn_mfma_f32_32x32x16_bf16(kf, qf[st], s, 0, 0, 0); }
        if (WIN) {
            if (kt == 0) {
#pragma unroll
                for (int r = 0; r < 16; ++r) if (crow(r, h) < ql) s[r] = -1e30f;
            }
            if (kt == 8) {
#pragma unroll
                for (int r = 0; r < 16; ++r) if (crow(r, h) > ql) s[r] = -1e30f;
            }
        }
        float mx = s[0];
#pragma unroll
        for (int r = 1; r < 16; ++r) mx = fmaxf(mx, s[r]);
        mx = fmaxf(mx, __shfl_xor(mx, 32));
        const float mxs = mx * cscale;
        if (__any(mxs > m_run + 8.0f)) {
            const float m_new = fmaxf(m_run, mxs), alpha = __builtin_amdgcn_exp2f(m_run - m_new);
            m_run = m_new; l_run *= alpha;
#pragma unroll
            for (int b = 0; b < DH / 32; ++b)
#pragma unroll
                for (int r = 0; r < 16; ++r) o[b][r] *= alpha;
        }
        const float nm = -m_run; float ps = 0.f;
#pragma unroll
        for (int r = 0; r < 16; ++r) { s[r] = __builtin_amdgcn_exp2f(__builtin_fmaf(s[r], cscale, nm)); ps += s[r]; }
        l_run += ps;
        bf16x8 pf[2];
#pragma unroll
        for (int s2 = 0; s2 < 2; ++s2) { u32x4 w; w.x = pk2(s[8 * s2 + 0], s[8 * s2 + 1]); w.y = pk2(s[8 * s2 + 2], s[8 * s2 + 3]); w.z = pk2(s[8 * s2 + 4], s[8 * s2 + 5]); w.w = pk2(s[8 * s2 + 6], s[8 * s2 + 7]); pf[s2] = __builtin_bit_cast(bf16x8, w); }
        const LAS unsigned char* vp = vbase + ((kt + koff) * 32) * vstr;
#pragma unroll
        for (int b = 0; b < DH / 32; ++b) {
#pragma unroll
            for (int s2 = 0; s2 < 2; ++s2) {
                const s16x4 lo = vtr(vp + (16 * s2) * vstr + b * 64), hi = vtr(vp + (16 * s2 + 8) * vstr + b * 64);
                const bf16x8 vf = (bf16x8){lo[0], lo[1], lo[2], lo[3], hi[0], hi[1], hi[2], hi[3]};
                o[b] = __builtin_amdgcn_mfma_f32_32x32x16_bf16(vf, pf[s2], o[b], 0, 0, 0);
            }
        }
    }
    { int d2 = ditem + (NIT - 1) * dstep; asm volatile("" : "+s"(d2)); const TItem8 dt = down_titem(d2, w_down, ws, lane); titem8_store_half(dt, 1, dv); }
    const float lt = l_run + __shfl_xor(l_run, 32), rl = 1.0f / lt;
    __syncthreads();
    if constexpr (O8) {
        constexpr int SST = DH + 16; const float rs = rl * SC_CAT;
#pragma unroll
        for (int b = 0; b < DH / 32; ++b)
#pragma unroll
            for (int rg = 0; rg < 4; ++rg) *(LAS unsigned*)(stg + ql * SST + (b * 32 + 8 * rg + 4 * h)) = pk4_fp8(o[b][4 * rg] * rs, o[b][4 * rg + 1] * rs, o[b][4 * rg + 2] * rs, o[b][4 * rg + 3] * rs);
        constexpr int CPR = DH / 16, RPI = 64 / CPR;
#pragma unroll
        for (int i = 0; i < 32 / RPI; ++i) { const int row = i * RPI + lane / CPR, ch = lane % CPR;
            const u32x4 v = *(const LAS u32x4*)(stg + row * SST + ch * 16);
            *(u32x4*)((unsigned char*)obase + (size_t)row * ldo + ch * 16) = v; }
    } else {
    constexpr int SST = DH * 2 + 16;
#pragma unroll
    for (int b = 0; b < DH / 32; ++b)
#pragma unroll
        for (int rg = 0; rg < 4; ++rg) { u32x2 w; w.x = pk2(o[b][4 * rg] * rl, o[b][4 * rg + 1] * rl); w.y = pk2(o[b][4 * rg + 2] * rl, o[b][4 * rg + 3] * rl);
            *(LAS u32x2*)(stg + ql * SST + (b * 32 + 8 * rg + 4 * h) * 2) = w; }
    constexpr int CPR = DH / 8, RPI = 64 / CPR;
#pragma unroll
    for (int i = 0; i < 32 / RPI; ++i) { const int row = i * RPI + lane / CPR, ch = lane % CPR;
        const u32x4 v = *(const LAS u32x4*)(stg + row * SST + ch * 16);
        *(u32x4*)(obase + (size_t)row * ldo + ch * 8) = v; }
    }
}

__device__ __forceinline__ void attn_win2(const LAS unsigned char* KL, int kstr, const LAS unsigned char* VL, int vstr, const bf16x8 (&qfA)[4], const bf16x8 (&qfB)[4],
                                          int j_lo, int j_hi, float m0, float cscale, unsigned char* obaseA, unsigned char* obaseB, int ldo, LAS unsigned char* stg, int lane, int ditem, const float* w_down, unsigned char* ws) {
    const int ql = lane & 31, h = lane >> 5;
    f32x16 oA[2], oB[2];
#pragma unroll
    for (int b = 0; b < 2; ++b)
#pragma unroll
        for (int r = 0; r < 16; ++r) { oA[b][r] = 0.f; oB[b][r] = 0.f; }
    float mA = m0, mB = m0, lA = h ? 0.f : 1.f, lB = h ? 0.f : 1.f;
    const LAS unsigned char* vbase = VL + (4 * h + ((lane & 15) >> 2)) * vstr + (16 * ((lane >> 4) & 1) + 4 * (lane & 3)) * 2;
#define WA_QK(S, QF) do { _Pragma("unroll") for (int r = 0; r < 16; ++r) S[r] = 0.f; \
        _Pragma("unroll") for (int st = 0; st < 4; ++st) { const bf16x8 kf_ = *(const LAS bf16x8*)(kp + st * 32); S = __builtin_amdgcn_mfma_f32_32x32x16_bf16(kf_, QF[st], S, 0, 0, 0); } } while (0)
#define WA_QK2(SA, SB) do { _Pragma("unroll") for (int r = 0; r < 16; ++r) { SA[r] = 0.f; SB[r] = 0.f; } \
        _Pragma("unroll") for (int st = 0; st < 4; ++st) { const bf16x8 kf_ = *(const LAS bf16x8*)(kp + st * 32); SA = __builtin_amdgcn_mfma_f32_32x32x16_bf16(kf_, qfA[st], SA, 0, 0, 0); SB = __builtin_amdgcn_mfma_f32_32x32x16_bf16(kf_, qfB[st], SB, 0, 0, 0); } } while (0)
#define WA_MASK_LO(S) do { _Pragma("unroll") for (int r = 0; r < 16; ++r) if (crow(r, h) < ql) S[r] = -1e30f; } while (0)
#define WA_MASK_HI(S) do { _Pragma("unroll") for (int r = 0; r < 16; ++r) if (crow(r, h) > ql) S[r] = -1e30f; } while (0)
#define WA_SMPV(S, O, MR, LR) do { float mx_ = S[0]; _Pragma("unroll") for (int r = 1; r < 16; ++r) mx_ = fmaxf(mx_, S[r]); \
        mx_ = fmaxf(mx_, __shfl_xor(mx_, 32)); const float mxs_ = mx_ * cscale; \
        if (__any(mxs_ > MR + 8.0f)) { const float mn_ = fmaxf(MR, mxs_), al_ = __builtin_amdgcn_exp2f(MR - mn_); MR = mn_; LR *= al_; \
            _Pragma("unroll") for (int b = 0; b < 2; ++b) _Pragma("unroll") for (int r = 0; r < 16; ++r) O[b][r] *= al_; } \
        const float nm_ = -MR; float ps_ = 0.f; \
        _Pragma("unroll") for (int r = 0; r < 16; ++r) { S[r] = __builtin_amdgcn_exp2f(__builtin_fmaf(S[r], cscale, nm_)); ps_ += S[r]; } \
        LR += ps_; \
        _Pragma("unroll") for (int s2 = 0; s2 < 2; ++s2) { u32x4 w_; w_.x = pk2(S[8 * s2 + 0], S[8 * s2 + 1]); w_.y = pk2(S[8 * s2 + 2], S[8 * s2 + 3]); w_.z = pk2(S[8 * s2 + 4], S[8 * s2 + 5]); w_.w = pk2(S[8 * s2 + 6], S[8 * s2 + 7]); \
            const bf16x8 pf_ = __builtin_bit_cast(bf16x8, w_); \
            _Pragma("unroll") for (int b = 0; b < 2; ++b) { const s16x4 lo_ = vtr(vp + (16 * s2) * vstr + b * 64), hi_ = vtr(vp + (16 * s2 + 8) * vstr + b * 64); \
                const bf16x8 vf_ = (bf16x8){lo_[0], lo_[1], lo_[2], lo_[3], hi_[0], hi_[1], hi_[2], hi_[3]}; O[b] = __builtin_amdgcn_mfma_f32_32x32x16_bf16(vf_, pf_, O[b], 0, 0, 0); } } } while (0)
    f32x4 dv[8];
    { int d0 = ditem; asm volatile("" : "+s"(d0)); const TItem8 dt = down_titem(d0, w_down, ws, lane); titem8_load_half(dt, 0, dv); }
    for (int j = j_lo; j < j_hi; ++j) {
        if (j == 5) { int d1 = ditem; asm volatile("" : "+s"(d1)); const TItem8 dt = down_titem(d1, w_down, ws, lane); titem8_store_half(dt, 0, dv); titem8_load_half(dt, 1, dv); }
        const LAS unsigned char* kp = KL + (j * 32 + ql) * kstr + h * 16;
        const LAS unsigned char* vp = vbase + (j * 32) * vstr;
        f32x16 sA, sB;
        if (j >= 2 && j <= 7) {
            WA_QK2(sA, sB);
            WA_SMPV(sA, oA, mA, lA); WA_SMPV(sB, oB, mB, lB);
        } else {
            if (j <= 8) { WA_QK(sA, qfA); if (j == 0) WA_MASK_LO(sA); if (j == 8) WA_MASK_HI(sA); WA_SMPV(sA, oA, mA, lA); }
            if (j >= 1) { WA_QK(sB, qfB); if (j == 1) WA_MASK_LO(sB); if (j == 9) WA_MASK_HI(sB); WA_SMPV(sB, oB, mB, lB); }
        }
    }
    { int d2 = ditem; asm volatile("" : "+s"(d2)); const TItem8 dt = down_titem(d2, w_down, ws, lane); titem8_store_half(dt, 1, dv); }
#undef WA_QK
#undef WA_QK2
#undef WA_MASK_LO
#undef WA_MASK_HI
#undef WA_SMPV
    const float rlA = 1.0f / (lA + __shfl_xor(lA, 32)), rlB = 1.0f / (lB + __shfl_xor(lB, 32));
    const float rsA = rlA * SC_CAT, rsB = rlB * SC_CAT;
#pragma unroll
    for (int t2 = 0; t2 < 2; ++t2) {
#pragma unroll
        for (int b = 0; b < 2; ++b)
#pragma unroll
            for (int rg = 0; rg < 4; ++rg) { unsigned w;
                if (t2 == 0) w = pk4_fp8(oA[b][4 * rg] * rsA, oA[b][4 * rg + 1] * rsA, oA[b][4 * rg + 2] * rsA, oA[b][4 * rg + 3] * rsA);
                else         w = pk4_fp8(oB[b][4 * rg] * rsB, oB[b][4 * rg + 1] * rsB, oB[b][4 * rg + 2] * rsB, oB[b][4 * rg + 3] * rsB);
                *(LAS unsigned*)(stg + ql * 80 + (b * 32 + 8 * rg + 4 * h)) = w; }
        unsigned char* ob = t2 ? obaseB : obaseA;
#pragma unroll
        for (int i = 0; i < 2; ++i) { const int row = i * 16 + (lane >> 2), ch = lane & 3;
            const u32x4 v = *(const LAS u32x4*)(stg + row * 80 + ch * 16);
            *(u32x4*)(ob + (size_t)row * ldo + ch * 16) = v; }
    }
}

template <bool O8, int NIT>
__device__ __forceinline__ void xattn_unit(const Ctx& C, int u, const bf16_t* PROJ, int ldp, int qcol0, int kvcol0, int ditem, int dstep, const float* w_down) {
    constexpr int KSTR = 272, VSTR = 288;
    LAS unsigned char* KL = C.lds; LAS unsigned char* VL = C.lds + 256 * KSTR;
    const int b = u >> 5, head = (u >> 3) & 3, qt = u & 7;
    const bf16_t* KV = WSP(bf16_t, WS_MEMKV) + (size_t)(b * MEML) * DM + kvcol0 + head * 128;
    const int row = b * SEQ + qt * 256 + C.wave * 32 + (C.lane & 31), h = C.lane >> 5;
    bf16x8 qf[8];
#pragma unroll
    for (int st = 0; st < 8; ++st) qf[st] = *(const bf16x8*)(PROJ + (size_t)row * ldp + qcol0 + head * 128 + st * 16 + h * 8);
    __syncthreads();
    {
        u32x4 kv[8], vv[8];
#pragma unroll
        for (int k = 0; k < 8; ++k) { const int it = C.tid + k * NTHR, i = it >> 4, c = it & 15;
            kv[k] = *(const u32x4*)(KV + (size_t)i * DM + c * 8); vv[k] = *(const u32x4*)(KV + (size_t)i * DM + 512 + c * 8); }
#pragma unroll
        for (int k = 0; k < 8; ++k) { const int it = C.tid + k * NTHR, i = it >> 4, c = it & 15;
            *(LAS u32x4*)(KL + i * KSTR + c * 16) = kv[k]; *(LAS u32x4*)(VL + i * VSTR + c * 16) = vv[k]; }
    }
    LDS_WAIT(); __syncthreads();
    bf16_t* ob = O8 ? (bf16_t*)(WSP(unsigned char, WS_CAT) + (size_t)(b * SEQ + qt * 256 + C.wave * 32) * DM + TOK + head * 128) : WSP(bf16_t, WS_CAT) + (size_t)(b * SEQ + qt * 256 + C.wave * 32) * DM + TOK + head * 128;
    attn_wave<128, false, O8, NIT>(KL, KSTR, VL, VSTR, qf, 0, 0, 8, -1e30f, 0.f, 0.08838834764831845f * LOG2E, ob, DM, KL + C.wave * (32 * 272), C.lane, ditem, dstep, w_down, C.ws);
}
__device__ __forceinline__ void wattn_unit(const Ctx& C0, int u, const float* sinkp, int ditem, const float* w_down) {
    Ctx C = C0; asm volatile("" : "+v"(C.tid), "+v"(C.lane));
    constexpr int KSTR = 144, VSTR = 192, NK = 320;
    LAS unsigned char* KL = C.lds; LAS unsigned char* VL = C.lds + NK * KSTR;
    const int b = u / 96, kvh = (u / 32) % 3, qt = u % 32, q0u = qt * 64, kbase = q0u - 128;
    const bf16_t* P = WSP(bf16_t, WS_PROJ);
    const float* RC = WSP(float, WS_ROPE); const float* RS = WSP(float, WS_ROPE + 512 * 1024);
    const int head = kvh * 8 + C.wave, h = C.lane >> 5;
    const float sk = sinkp[head] * LOG2E;
    bf16x8 qf[2][4]; f32x4 qc0[2], qc1[2], qs0[2], qs1[2];
#pragma unroll
    for (int t2 = 0; t2 < 2; ++t2) {
        const size_t row = (size_t)(b * SEQ + q0u + t2 * 32 + (C.lane & 31));
#pragma unroll
        for (int st = 0; st < 4; ++st) qf[t2][st] = *(const bf16x8*)(P + row * AINP + head * 64 + st * 16 + h * 8);
        qc0[t2] = *(const f32x4*)(RC + row * 8); qc1[t2] = *(const f32x4*)(RC + row * 8 + 4); qs0[t2] = *(const f32x4*)(RS + row * 8); qs1[t2] = *(const f32x4*)(RS + row * 8 + 4);
    }

    __syncthreads();
    {
        u32x4 kv[4], vv[5];
#pragma unroll
        for (int k = 0; k < 4; ++k) { const int it = C.tid + k * NTHR, i = it / 6, c = 2 + it % 6, kpos = kbase + i;
            kv[k] = (it < NK * 6 && kpos >= 0 && kpos < SEQ) ? *(const u32x4*)(P + (size_t)(b * SEQ + kpos) * AINP + TOK + kvh * 64 + c * 8) : (u32x4){0u, 0u, 0u, 0u}; }
#pragma unroll
        for (int k = 0; k < 5; ++k) { const int it = C.tid + k * NTHR, i = it >> 3, c = it & 7, kpos = kbase + i;
            vv[k] = (kpos >= 0 && kpos < SEQ) ? *(const u32x4*)(P + (size_t)(b * SEQ + kpos) * AINP + TOK + KVW + kvh * 64 + c * 8) : (u32x4){0u, 0u, 0u, 0u}; }
        if (C.tid < NK) {
            const int i = C.tid, kpos = kbase + i;
            if (kpos >= 0 && kpos < SEQ) {
                const size_t rowi = (size_t)(b * SEQ + kpos);
                const bf16_t* kr = P + rowi * AINP + TOK + kvh * 64;
                const u32x4 k1 = *(const u32x4*)kr, k2 = *(const u32x4*)(kr + 8);
                const f32x4 c0 = *(const f32x4*)(RC + rowi * 8), c1 = *(const f32x4*)(RC + rowi * 8 + 4), s0 = *(const f32x4*)(RS + rowi * 8), s1 = *(const f32x4*)(RS + rowi * 8 + 4);
                u32x4 n1, n2;
                n1.x = pk2(lo16(k1.x) * c0.x - lo16(k2.x) * s0.x, hi16(k1.x) * c0.y - hi16(k2.x) * s0.y); n2.x = pk2(lo16(k2.x) * c0.x + lo16(k1.x) * s0.x, hi16(k2.x) * c0.y + hi16(k1.x) * s0.y);
                n1.y = pk2(lo16(k1.y) * c0.z - lo16(k2.y) * s0.z, hi16(k1.y) * c0.w - hi16(k2.y) * s0.w); n2.y = pk2(lo16(k2.y) * c0.z + lo16(k1.y) * s0.z, hi16(k2.y) * c0.w + hi16(k1.y) * s0.w);
                n1.z = pk2(lo16(k1.z) * c1.x - lo16(k2.z) * s1.x, hi16(k1.z) * c1.y - hi16(k2.z) * s1.y); n2.z = pk2(lo16(k2.z) * c1.x + lo16(k1.z) * s1.x, hi16(k2.z) * c1.y + hi16(k1.z) * s1.y);
                n1.w = pk2(lo16(k1.w) * c1.z - lo16(k2.w) * s1.z, hi16(k1.w) * c1.w - hi16(k2.w) * s1.w); n2.w = pk2(lo16(k2.w) * c1.z + lo16(k1.w) * s1.z, hi16(k2.w) * c1.w + hi16(k1.w) * s1.w);
                *(LAS u32x4*)(KL + i * KSTR) = n1; *(LAS u32x4*)(KL + i * KSTR + 16) = n2;
            }
        }
#pragma unroll
        for (int k = 0; k < 4; ++k) { const int it = C.tid + k * NTHR, i = it / 6, c = 2 + it % 6; if (it < NK * 6) *(LAS u32x4*)(KL + i * KSTR + c * 16) = kv[k]; }
#pragma unroll
        for (int k = 0; k < 5; ++k) { const int it = C.tid + k * NTHR, i = it >> 3, c = it & 7; *(LAS u32x4*)(VL + i * VSTR + c * 16) = vv[k]; }
    }
#pragma unroll
    for (int t2 = 0; t2 < 2; ++t2) {
        const u32x4 mine = __builtin_bit_cast(u32x4, qf[t2][0]);
        u32x4 oth; oth.x = __shfl_xor(mine.x, 32); oth.y = __shfl_xor(mine.y, 32); oth.z = __shfl_xor(mine.z, 32); oth.w = __shfl_xor(mine.w, 32);
        const f32x4 c0 = qc0[t2], c1 = qc1[t2], s0 = qs0[t2], s1 = qs1[t2];
        const float sg = h ? 1.f : -1.f;
        u32x4 nv;
        nv.x = pk2(lo16(mine.x) * c0.x + sg * lo16(oth.x) * s0.x, hi16(mine.x) * c0.y + sg * hi16(oth.x) * s0.y);
        nv.y = pk2(lo16(mine.y) * c0.z + sg * lo16(oth.y) * s0.z, hi16(mine.y) * c0.w + sg * hi16(oth.y) * s0.w);
        nv.z = pk2(lo16(mine.z) * c1.x + sg * lo16(oth.z) * s1.x, hi16(mine.z) * c1.y + sg * hi16(oth.z) * s1.y);
        nv.w = pk2(lo16(mine.w) * c1.z + sg * lo16(oth.w) * s1.z, hi16(mine.w) * c1.w + sg * hi16(oth.w) * s1.w);
        qf[t2][0] = __builtin_bit_cast(bf16x8, nv);
    }
    LDS_WAIT(); __syncthreads();
    {
        const size_t rowA = (size_t)(b * SEQ + q0u + (C.lane & 31));
        const int j_lo = q0u >= 128 ? 0 : (128 - q0u) / 32;
        int j_hi = (SEQ + 128 - q0u) / 32; if (j_hi > 10) j_hi = 10;
        const size_t row0 = (size_t)(b * SEQ + q0u);
        attn_win2(KL, KSTR, VL, VSTR, qf[0], qf[1], j_lo, j_hi, sk, 0.125f * LOG2E, WSP(unsigned char, WS_CAT) + row0 * DM + head * 64, WSP(unsigned char, WS_CAT) + (row0 + 32) * DM + head * 64, DM, VL + NK * VSTR + C.wave * (32 * 144), C.lane, ditem, w_down, C.ws);
    }
}

template <int HW>
__device__ __forceinline__ void pool_item4(const bf16_t* P, bf16_t* O, int m0, int c) {
    const int t0 = m0 & (SEQ - 1);
    const bf16_t* base = P + (size_t)(m0 - t0) * DM + c * 8;
    constexpr int NR = 2 * HW + 3;
    u32x4 v[NR];
#pragma unroll
    for (int jj = 0; jj < NR; ++jj) { int j = t0 - HW + jj; j = j < 0 ? 0 : (j > SEQ - 1 ? SEQ - 1 : j); v[jj] = *(const u32x4*)(base + (size_t)j * DM); }
    float a[8];
#pragma unroll
    for (int k = 0; k < 8; ++k) a[k] = 0.f;
#pragma unroll
    for (int jj = 0; jj < 2 * HW; ++jj) { const int j = t0 - HW + jj; const float wv = (j >= 0 && j < SEQ) ? 1.f : 0.f;
        a[0] += wv * lo16(v[jj].x); a[1] += wv * hi16(v[jj].x); a[2] += wv * lo16(v[jj].y); a[3] += wv * hi16(v[jj].y);
        a[4] += wv * lo16(v[jj].z); a[5] += wv * hi16(v[jj].z); a[6] += wv * lo16(v[jj].w); a[7] += wv * hi16(v[jj].w); }
#pragma unroll
    for (int i = 0; i < 4; ++i) {
        const int t = t0 + i;
        if (i > 0) {
            const int jo = t - 1 - HW, jn = t + HW - 1; const float wo = (jo >= 0) ? 1.f : 0.f, wn = (jn < SEQ) ? 1.f : 0.f;
            const u32x4 vo = v[i - 1], vn = v[2 * HW + i - 1];
            a[0] += wn * lo16(vn.x) - wo * lo16(vo.x); a[1] += wn * hi16(vn.x) - wo * hi16(vo.x); a[2] += wn * lo16(vn.y) - wo * lo16(vo.y); a[3] += wn * hi16(vn.y) - wo * hi16(vo.y);
            a[4] += wn * lo16(vn.z) - wo * lo16(vo.z); a[5] += wn * hi16(vn.z) - wo * hi16(vo.z); a[6] += wn * lo16(vn.w) - wo * lo16(vo.w); a[7] += wn * hi16(vn.w) - wo * hi16(vo.w);
        }
        int lo = t - HW; if (lo < 0) lo = 0; int hi = t + HW - 1; if (hi > SEQ - 1) hi = SEQ - 1;
        const float rc = 1.0f / (float)(hi - lo + 1);
        const u32x4 sv = v[HW + i];
        u32x4 o; o.x = pk2(a[0] * rc - lo16(sv.x), a[1] * rc - hi16(sv.x)); o.y = pk2(a[2] * rc - lo16(sv.y), a[3] * rc - hi16(sv.y));
        o.z = pk2(a[4] * rc - lo16(sv.z), a[5] * rc - hi16(sv.z)); o.w = pk2(a[6] * rc - lo16(sv.w), a[7] * rc - hi16(sv.w));
        *(u32x4*)(O + (size_t)(m0 + i) * DM + c * 8) = o;
    }
}
__device__ __forceinline__ void pool_phase(const Ctx& C) {
    const bf16_t* P = WSP(bf16_t, WS_PROJ); bf16_t* O = WSP(bf16_t, WS_CAT);
    if (C.lane >= 48) return;
    for (int wi = C.rb; wi < C.re; wi += C.rs) {
        const int g = wi & 3, m0 = 4 * (wi >> 2), c = g * 48 + C.lane;
        if (g == 0) pool_item4<1>(P, O, m0, c); else if (g == 1) pool_item4<2>(P, O, m0, c); else if (g == 2) pool_item4<4>(P, O, m0, c); else pool_item4<8>(P, O, m0, c);
    }
}

__device__ __forceinline__ void router_phase(const Ctx& C, const bf16_t* X, const float* g, const float* Wr) {
    LAS float* WL = (LAS float*)C.lds;
    __syncthreads();
    for (int idx = C.tid; idx < DM * NE / 4; idx += NTHR) { const f32x4 w = *(const f32x4*)(Wr + (size_t)idx * 4); const int k = idx >> 2, e0 = (idx & 3) * 4;
        WL[(e0 + 0) * DM + k] = w.x; WL[(e0 + 1) * DM + k] = w.y; WL[(e0 + 2) * DM + k] = w.z; WL[(e0 + 3) * DM + k] = w.w; }
    LDS_WAIT(); __syncthreads();
    unsigned char* XN8 = WSP(unsigned char, WS_XN8); float* AFFT = WSP(float, WS_AFFT);
    u32x2 xa[8], xb[8]; f32x4 gq[8];
#pragma unroll
    for (int jj = 0; jj < 8; ++jj) gq[jj] = *(const f32x4*)(g + 4 * C.lane + 256 * jj);
    if (C.gw < M) {
        const int mb = (C.gw + C.NGW < M) ? C.gw + C.NGW : C.gw;
#pragma unroll
        for (int jj = 0; jj < 8; ++jj) { xa[jj] = *(const u32x2*)(X + (size_t)C.gw * DM + 4 * C.lane + 256 * jj); xb[jj] = *(const u32x2*)(X + (size_t)mb * DM + 4 * C.lane + 256 * jj); }
    }
    for (int m0 = C.gw; m0 < M; m0 += 2 * C.NGW) {
        const bool two = m0 + C.NGW < M; const int m1 = two ? m0 + C.NGW : m0;
        u32x2 ca[8], cb[8]; float ssa = 0.f, ssb = 0.f;
#pragma unroll
        for (int jj = 0; jj < 8; ++jj) { ca[jj] = xa[jj]; cb[jj] = xb[jj];
            const float a0 = lo16(ca[jj].x), a1 = hi16(ca[jj].x), a2 = lo16(ca[jj].y), a3 = hi16(ca[jj].y), b0 = lo16(cb[jj].x), b1 = hi16(cb[jj].x), b2_ = lo16(cb[jj].y), b3_ = hi16(cb[jj].y);
            ssa += (a0 * a0 + a1 * a1) + (a2 * a2 + a3 * a3); ssb += (b0 * b0 + b1 * b1) + (b2_ * b2_ + b3_ * b3_); }
        { const int na = (m0 + 2 * C.NGW < M) ? m0 + 2 * C.NGW : m0, nb = (m0 + 3 * C.NGW < M) ? m0 + 3 * C.NGW : na;
#pragma unroll
          for (int jj = 0; jj < 8; ++jj) { xa[jj] = *(const u32x2*)(X + (size_t)na * DM + 4 * C.lane + 256 * jj); xb[jj] = *(const u32x2*)(X + (size_t)nb * DM + 4 * C.lane + 256 * jj); } }
        const float ra = 1.0f / sqrtf(wave_sum(ssa) * (1.0f / DM) + EPS), rb = 1.0f / sqrtf(wave_sum(ssb) * (1.0f / DM) + EPS);
        f32x2 lab[NE];
#pragma unroll
        for (int e = 0; e < NE; ++e) lab[e] = (f32x2){0.f, 0.f};
#pragma unroll
        for (int jj = 0; jj < 8; ++jj) {
            const f32x4 a = (f32x4){lo16(ca[jj].x), hi16(ca[jj].x), lo16(ca[jj].y), hi16(ca[jj].y)} * ra * gq[jj], b = (f32x4){lo16(cb[jj].x), hi16(cb[jj].x), lo16(cb[jj].y), hi16(cb[jj].y)} * rb * gq[jj];
            *(unsigned*)(XN8 + (size_t)m0 * DM + 4 * C.lane + 256 * jj) = pk4_fp8(a.x * pg8::SC_X, a.y * pg8::SC_X, a.z * pg8::SC_X, a.w * pg8::SC_X);
            *(unsigned*)(XN8 + (size_t)m1 * DM + 4 * C.lane + 256 * jj) = pk4_fp8(b.x * pg8::SC_X, b.y * pg8::SC_X, b.z * pg8::SC_X, b.w * pg8::SC_X);
            const f32x2 p0 = {a.x, b.x}, p1 = {a.y, b.y}, p2 = {a.z, b.z}, p3 = {a.w, b.w};
#pragma unroll
            for (int e = 0; e < NE; ++e) { const f32x4 w = *(const LAS f32x4*)(WL + e * DM + 256 * jj + 4 * C.lane);
                lab[e] = __builtin_elementwise_fma(p0, (f32x2){w.x, w.x}, lab[e]); lab[e] = __builtin_elementwise_fma(p1, (f32x2){w.y, w.y}, lab[e]);
                lab[e] = __builtin_elementwise_fma(p2, (f32x2){w.z, w.z}, lab[e]); lab[e] = __builtin_elementwise_fma(p3, (f32x2){w.w, w.w}, lab[e]);
                if ((e & 7) == 7) asm volatile("" : "+v"(lab[e]) :: "memory"); }
        }
        const bool b5 = C.lane & 32, b4 = C.lane & 16, b3 = C.lane & 8, b2 = C.lane & 4;
        const int eidx = ((C.lane >> 5) & 1) * 8 + ((C.lane >> 4) & 1) * 4 + ((C.lane >> 3) & 1) * 2 + ((C.lane >> 2) & 1);
#pragma unroll
        for (int rr = 0; rr < 2; ++rr) {
            float v8[8], v4[4], v2[2];
#pragma unroll
            for (int i = 0; i < 8; ++i) { const float lo = rr ? lab[i].y : lab[i].x, hi = rr ? lab[8 + i].y : lab[8 + i].x; v8[i] = (b5 ? hi : lo) + __shfl_xor(b5 ? lo : hi, 32); }
#pragma unroll
            for (int i = 0; i < 4; ++i) v4[i] = (b4 ? v8[4 + i] : v8[i]) + __shfl_xor(b4 ? v8[i] : v8[4 + i], 16);
#pragma unroll
            for (int i = 0; i < 2; ++i) v2[i] = (b3 ? v4[2 + i] : v4[i]) + __shfl_xor(b3 ? v4[i] : v4[2 + i], 8);
            float lgt = (b2 ? v2[1] : v2[0]) + __shfl_xor(b2 ? v2[0] : v2[1], 4);
            lgt += __shfl_xor(lgt, 2); lgt += __shfl_xor(lgt, 1);
            float mx = lgt;
            mx = fmaxf(mx, __shfl_xor(mx, 32)); mx = fmaxf(mx, __shfl_xor(mx, 16)); mx = fmaxf(mx, __shfl_xor(mx, 8)); mx = fmaxf(mx, __shfl_xor(mx, 4));
            const float ex = __expf(lgt - mx);
            float se = ex;
            se += __shfl_xor(se, 32); se += __shfl_xor(se, 16); se += __shfl_xor(se, 8); se += __shfl_xor(se, 4);
            const int m = rr ? m1 : m0;
            if ((C.lane & 3) == 0 && (rr == 0 || two)) AFFT[((size_t)(m >> 11) * NE + eidx) * SEQ + (m & (SEQ - 1))] = ex / se;
        }
    }
}

__device__ __forceinline__ void router_phase_mfma(const Ctx& C, const bf16_t* X, const float* g, const bf16_t* WRT) {
    constexpr int RS = 4112;
    LAS unsigned char* T = C.lds; LAS float* PART = (LAS float*)(C.lds + 32 * RS);
    unsigned char* XN8 = WSP(unsigned char, WS_XN8); float* AFFT = WSP(float, WS_AFFT);
    const int l15 = C.lane & 15, kq = C.lane >> 4;
    bf16x8 bhi[8], blo[8];
#pragma unroll
    for (int s2 = 0; s2 < 8; ++s2) { const bf16_t* wp = WRT + (size_t)l15 * DM + 256 * C.wave + 32 * s2 + 8 * kq; bhi[s2] = *(const bf16x8*)wp; blo[s2] = *(const bf16x8*)(wp + NE * DM); }
    f32x4 gq[8];
#pragma unroll
    for (int jj = 0; jj < 8; ++jj) gq[jj] = *(const f32x4*)(g + 4 * C.lane + 256 * jj);
    u32x2 xr[4][8];
#pragma unroll
    for (int i = 0; i < 4; ++i)
#pragma unroll
        for (int jj = 0; jj < 8; ++jj) xr[i][jj] = *(const u32x2*)(X + (size_t)(C.rb + i * C.rs) * DM + 4 * C.lane + 256 * jj);
#pragma unroll
    for (int p = 0; p < 2; ++p) {
        __syncthreads();
#pragma unroll
        for (int i = 0; i < 4; ++i) {
            const int m = C.rb + (4 * p + i) * C.rs;
            float ss = 0.f;
#pragma unroll
            for (int jj = 0; jj < 8; ++jj) { const float a0 = lo16(xr[i][jj].x), a1 = hi16(xr[i][jj].x), a2 = lo16(xr[i][jj].y), a3 = hi16(xr[i][jj].y); ss += (a0 * a0 + a1 * a1) + (a2 * a2 + a3 * a3); }
            const float r = 1.0f / sqrtf(wave_sum(ss) * (1.0f / DM) + EPS);
#pragma unroll
            for (int jj = 0; jj < 8; ++jj) {
                const f32x4 a = (f32x4){lo16(xr[i][jj].x), hi16(xr[i][jj].x), lo16(xr[i][jj].y), hi16(xr[i][jj].y)} * r * gq[jj];
                *(unsigned*)(XN8 + (size_t)m * DM + 4 * C.lane + 256 * jj) = pk4_fp8(a.x * pg8::SC_X, a.y * pg8::SC_X, a.z * pg8::SC_X, a.w * pg8::SC_X);
                u32x2 o; o.x = pk2(a.x, a.y); o.y = pk2(a.z, a.w);
                *(LAS u32x2*)(T + (4 * C.wave + i) * RS + (4 * C.lane + 256 * jj) * 2) = o;
            }
        }
        if (p == 0) {
#pragma unroll
            for (int i = 0; i < 4; ++i)
#pragma unroll
                for (int jj = 0; jj < 8; ++jj) xr[i][jj] = *(const u32x2*)(X + (size_t)(C.rb + (4 + i) * C.rs) * DM + 4 * C.lane + 256 * jj);
        }
        LDS_WAIT(); __syncthreads();
        f32x4 acc0 = {0.f, 0.f, 0.f, 0.f}, acc1 = {0.f, 0.f, 0.f, 0.f};
#pragma unroll
        for (int s2 = 0; s2 < 8; ++s2) {
            const bf16x8 a0 = *(const LAS bf16x8*)(T + l15 * RS + (256 * C.wave + 32 * s2 + 8 * kq) * 2), a1 = *(const LAS bf16x8*)(T + (16 + l15) * RS + (256 * C.wave + 32 * s2 + 8 * kq) * 2);
            acc0 = __builtin_amdgcn_mfma_f32_16x16x32_bf16(a0, bhi[s2], acc0, 0, 0, 0); acc0 = __builtin_amdgcn_mfma_f32_16x16x32_bf16(a0, blo[s2], acc0, 0, 0, 0);
            acc1 = __builtin_amdgcn_mfma_f32_16x16x32_bf16(a1, bhi[s2], acc1, 0, 0, 0); acc1 = __builtin_amdgcn_mfma_f32_16x16x32_bf16(a1, blo[s2], acc1, 0, 0, 0);
        }
#pragma unroll
        for (int rg = 0; rg < 4; ++rg) { PART[(C.wave * 32 + 4 * kq + rg) * NE + l15] = acc0[rg]; PART[(C.wave * 32 + 16 + 4 * kq + rg) * NE + l15] = acc1[rg]; }
        LDS_WAIT(); __syncthreads();
        {   const int row = C.tid >> 4, e = C.tid & 15;
            float lg = 0.f;
#pragma unroll
            for (int w = 0; w < 8; ++w) lg += PART[(w * 32 + row) * NE + e];
            float mx = lg; mx = fmaxf(mx, __shfl_xor(mx, 1)); mx = fmaxf(mx, __shfl_xor(mx, 2)); mx = fmaxf(mx, __shfl_xor(mx, 4)); mx = fmaxf(mx, __shfl_xor(mx, 8));
            const float ex = __expf(lg - mx); float se = ex; se += __shfl_xor(se, 1); se += __shfl_xor(se, 2); se += __shfl_xor(se, 4); se += __shfl_xor(se, 8);
            const int m = (C.rb - C.wave) + (row >> 2) + (4 * p + (row & 3)) * C.rs;
            AFFT[((size_t)(m >> 11) * NE + e) * SEQ + (m & (SEQ - 1))] = ex / se; }
    }
}

__device__ __forceinline__ unsigned wave_cnt4(bool f0, bool f1, bool f2, bool f3) {
    return (unsigned)(__builtin_popcountll(__ballot(f0)) + __builtin_popcountll(__ballot(f1)) + __builtin_popcountll(__ballot(f2)) + __builtin_popcountll(__ballot(f3)));
}
__device__ __forceinline__ unsigned lanes_below(bool f) { const unsigned long long m = __ballot(f); return __builtin_amdgcn_mbcnt_hi((unsigned)(m >> 32), __builtin_amdgcn_mbcnt_lo((unsigned)m, 0u)); }
__device__ __forceinline__ void rank_phase(const Ctx& C) {
    LAS unsigned* CN = (LAS unsigned*)C.lds;
    const float* AFFT = WSP(float, WS_AFFT); int* IDX = WSP(int, WS_IDX); float* GATE = WSP(float, WS_IDX + 512 * 1024); int* SEL = WSP(int, WS_SEL);
    const int u0 = (C.G == 256) ? (((int)blockIdx.x >> 3) < NE ? ((int)blockIdx.x & 7) * NE + ((int)blockIdx.x >> 3) : NB * NE) : (int)blockIdx.x;
    for (int u = u0; u < NB * NE; u += C.G) {
        const int b = u >> 4, e = u & 15;
        __syncthreads();
        if (C.tid < 64) CN[C.tid] = 0u;
        const f32x4 av = ((const f32x4*)(AFFT + (size_t)(b * NE + e) * SEQ))[C.tid];
        const unsigned k0 = __float_as_uint(av.x), k1 = __float_as_uint(av.y), k2 = __float_as_uint(av.z), k3 = __float_as_uint(av.w);
        LDS_WAIT(); __syncthreads();
        unsigned T = 0u;
        for (int bit = 29; bit >= 0; --bit) {
            const unsigned cand = T | (1u << bit);
            const unsigned ws = wave_cnt4(k0 >= cand, k1 >= cand, k2 >= cand, k3 >= cand);
            if (C.lane == 0) __hip_atomic_fetch_add(CN + bit, ws, __ATOMIC_RELAXED, __HIP_MEMORY_SCOPE_WORKGROUP);
            LDS_WAIT(); __syncthreads();
            if (CN[bit] >= (unsigned)CAP) T = cand;
        }
        { const unsigned ws = wave_cnt4(k0 > T, k1 > T, k2 > T, k3 > T);
          if (C.lane == 0) __hip_atomic_fetch_add(CN + 30, ws, __ATOMIC_RELAXED, __HIP_MEMORY_SCOPE_WORKGROUP); }
        const bool q0 = k0 == T, q1 = k1 == T, q2 = k2 == T, q3 = k3 == T;
        const unsigned qpre = lanes_below(q0) + lanes_below(q1) + lanes_below(q2) + lanes_below(q3);
        { const unsigned wt = wave_cnt4(q0, q1, q2, q3); if (C.lane == 0) CN[32 + C.wave] = wt; }
        LDS_WAIT(); __syncthreads();
        const unsigned need = (unsigned)CAP - CN[30];
        unsigned qb = qpre;
#pragma unroll
        for (int w = 0; w < 8; ++w) qb += (w < C.wave) ? CN[32 + w] : 0u;
        const bool s0 = k0 > T || (q0 && qb < need);
        const bool s1 = k1 > T || (q1 && qb + (q0 ? 1u : 0u) < need);
        const bool s2 = k2 > T || (q2 && qb + (q0 ? 1u : 0u) + (q1 ? 1u : 0u) < need);
        const bool s3 = k3 > T || (q3 && qb + (q0 ? 1u : 0u) + (q1 ? 1u : 0u) + (q2 ? 1u : 0u) < need);
        const unsigned spre = lanes_below(s0) + lanes_below(s1) + lanes_below(s2) + lanes_below(s3);
        { const unsigned wt = wave_cnt4(s0, s1, s2, s3); if (C.lane == 0) CN[40 + C.wave] = wt; }
        LDS_WAIT(); __syncthreads();
        unsigned sb = spre;
#pragma unroll
        for (int w = 0; w < 8; ++w) sb += (w < C.wave) ? CN[40 + w] : 0u;
        const int t0 = 4 * C.tid, row0 = b * SEQ + t0, ob = (e * NB + b) * CAP;
        const unsigned p0 = sb, p1 = p0 + (s0 ? 1u : 0u), p2 = p1 + (s1 ? 1u : 0u), p3 = p2 + (s2 ? 1u : 0u);
        if (s0) { IDX[ob + p0] = row0;     GATE[ob + p0] = av.x; }
        if (s1) { IDX[ob + p1] = row0 + 1; GATE[ob + p1] = av.y; }
        if (s2) { IDX[ob + p2] = row0 + 2; GATE[ob + p2] = av.z; }
        if (s3) { IDX[ob + p3] = row0 + 3; GATE[ob + p3] = av.w; }
        SEL[(size_t)(row0 + 0) * NE + e] = s0 ? (int)p0 : -1; SEL[(size_t)(row0 + 1) * NE + e] = s1 ? (int)p1 : -1;
        SEL[(size_t)(row0 + 2) * NE + e] = s2 ? (int)p2 : -1; SEL[(size_t)(row0 + 3) * NE + e] = s3 ? (int)p3 : -1;
    }
}

template <bool FINAL>
__device__ __forceinline__ void combine_phase(const Ctx& C, bf16_t* X, const float* g, float* OUT) {
    const int* SEL = WSP(int, WS_SEL); const unsigned char* Y = WSP(unsigned char, WS_Y); unsigned char* XN = WSP(unsigned char, WS_XN8);
    int cc[2][2];
#pragma unroll
    for (int j = 0; j < 2; ++j) { const int q = C.lane + 64 * j; cc[j][0] = (q >> 4) * 256 + (q & 15) * 8; cc[j][1] = cc[j][0] + 128; }
    int svn = -1; u32x4 xn[2][2]; f32x4 gq[2][2][2];
#pragma unroll
    for (int j = 0; j < 2; ++j)
#pragma unroll
        for (int k = 0; k < 2; ++k) { gq[j][k][0] = *(const f32x4*)(g + cc[j][k]); gq[j][k][1] = *(const f32x4*)(g + cc[j][k] + 4); }
    if (C.rb < C.re) { svn = C.lane < NE ? SEL[(size_t)C.rb * NE + C.lane] : -1;
#pragma unroll
        for (int j = 0; j < 2; ++j)
#pragma unroll
            for (int k = 0; k < 2; ++k) xn[j][k] = *(const u32x4*)(X + (size_t)C.rb * DM + cc[j][k]); }
    for (int m = C.rb; m < C.re; m += C.rs) {
        const int sv = svn;
        unsigned long long mask = __ballot(sv >= 0);
        bf16_t* xr = X + (size_t)m * DM;
        f32x4 v[2][2][2];
#pragma unroll
        for (int j = 0; j < 2; ++j)
#pragma unroll
            for (int k = 0; k < 2; ++k) { const u32x4 y = xn[j][k];
                v[j][k][0] = (f32x4){lo16(y.x), hi16(y.x), lo16(y.y), hi16(y.y)}; v[j][k][1] = (f32x4){lo16(y.z), hi16(y.z), lo16(y.w), hi16(y.w)}; }
        { const int mn = (m + C.rs < C.re) ? m + C.rs : m;
          svn = C.lane < NE ? SEL[(size_t)mn * NE + C.lane] : -1;
#pragma unroll
          for (int j = 0; j < 2; ++j)
#pragma unroll
              for (int k = 0; k < 2; ++k) xn[j][k] = *(const u32x4*)(X + (size_t)mn * DM + cc[j][k]); }
        const int b = m >> 11;
        while (mask) {
            const int e = __builtin_ctzll(mask); mask &= mask - 1;
            const int slot = __builtin_amdgcn_readlane(sv, e);
            const unsigned char* yr = Y + (size_t)(e * ER + b * CAP + slot) * DM + 16 * C.lane;
#pragma unroll
            for (int j = 0; j < 2; ++j) { const u32x4 y = __builtin_nontemporal_load((const u32x4*)(yr + 1024 * j));
                v[j][0][0] += up4_fp8(y.x) * Y_INV; v[j][0][1] += up4_fp8(y.y) * Y_INV; v[j][1][0] += up4_fp8(y.z) * Y_INV; v[j][1][1] += up4_fp8(y.w) * Y_INV; }
        }
        float ss = 0.f;
#pragma unroll
        for (int j = 0; j < 2; ++j)
#pragma unroll
            for (int k = 0; k < 2; ++k)
#pragma unroll
                for (int q = 0; q < 2; ++q) ss += (v[j][k][q].x * v[j][k][q].x + v[j][k][q].y * v[j][k][q].y) + (v[j][k][q].z * v[j][k][q].z + v[j][k][q].w * v[j][k][q].w);
        const float r = 1.0f / sqrtf(wave_sum(ss) * (1.0f / DM) + EPS);
#pragma unroll
        for (int j = 0; j < 2; ++j)
#pragma unroll
            for (int k = 0; k < 2; ++k) {
                const f32x4 a = v[j][k][0] * r * gq[j][k][0], bb = v[j][k][1] * r * gq[j][k][1];
                if (FINAL) { float* orow = OUT + (size_t)m * DM + cc[j][k]; __builtin_nontemporal_store(a, (f32x4*)orow); __builtin_nontemporal_store(bb, (f32x4*)(orow + 4)); }
                else { u32x4 xo; xo.x = pk2(v[j][k][0].x, v[j][k][0].y); xo.y = pk2(v[j][k][0].z, v[j][k][0].w); xo.z = pk2(v[j][k][1].x, v[j][k][1].y); xo.w = pk2(v[j][k][1].z, v[j][k][1].w);
                    *(u32x4*)(xr + cc[j][k]) = xo;
                    u32x2 o; o.x = pk4_fp8(a.x * 8.0f, a.y * 8.0f, a.z * 8.0f, a.w * 8.0f); o.y = pk4_fp8(bb.x * 8.0f, bb.y * 8.0f, bb.z * 8.0f, bb.w * 8.0f);
                    *(u32x2*)(XN + (size_t)m * DM + cc[j][k]) = o; }
            }
    }
}

struct Args { const void* in[19]; float* out; unsigned char* ws; int ph_lo, ph_hi; };
constexpr int NPHASE = 18;

__global__ void __launch_bounds__(NTHR, 2) mk_fwd(Args args) {
    extern __shared__ __attribute__((aligned(16))) unsigned char lds_raw[];
    Ctx C;
    C.lds = (LAS unsigned char*)lds_raw;
    C.tid = threadIdx.x; C.lane = C.tid & 63; C.wave = __builtin_amdgcn_readfirstlane(C.tid >> 6);
    C.G = gridDim.x; C.gw = blockIdx.x * NWAVES + C.wave; C.NGW = C.G * NWAVES;
    if (C.G == 256) { const int v = (int)blockIdx.x & 7, lr = (int)blockIdx.x >> 3; C.rb = v * SEQ + lr * NWAVES + C.wave; C.rs = 32 * NWAVES; C.re = (v + 1) * SEQ; }
    else { C.rb = C.gw; C.rs = C.NGW; C.re = M; }
    C.ws = args.ws; C.ctl = (gu32*)(args.ws + WS_CTL);
#define INF(k) ((const float*)args.in[k])
    volatile LAS unsigned* MISC = (volatile LAS unsigned*)(C.lds + MISC_OFF);
    LAS int* tab = (LAS int*)(C.lds + TAB_OFF);
    for (int u = C.tid; u < 64; u += NTHR) ((LAS unsigned*)(C.lds + MISC_OFF))[u] = 0u;
    __syncthreads();
    XcdBarrier bar; bar.bar = (unsigned*)(C.ctl + CW_BAR); bar.x = 0; bar.st = nullptr;
#if !MK_PER_PHASE
    bar = xcd_barrier_post((unsigned*)(C.ctl + CW_BAR), MISC + 8);
#define GRID_BAR() xcd_barrier(bar)
#define LOCAL_BAR() do { if (lok) { lgen += 32u; xcd_local_barrier(bar, lgen); } else xcd_barrier(bar); } while (0)
    if (C.tid == 0 && (xb_xcc_id() != (blockIdx.x & 7u) || gridDim.x != 256u)) atomicAdd(&bar.bar[XB_BAD], 1u);
#else
#define GRID_BAR() do {} while (0)
#define LOCAL_BAR() do {} while (0)
#endif
    bool lok = false; unsigned lgen = 0u;
    const int lo = args.ph_lo, hi = args.ph_hi;
#ifndef PHASE_MASK
#define PHASE_MASK 0x3ffff
#endif
#define IN(k) (((PHASE_MASK >> (k)) & 1) && lo <= (k) && (k) < hi)
#ifndef REP_MASK
#define REP_MASK 0x0
#endif
#define REPS(k) for (int rep_ = 0; rep_ < (((REP_MASK >> (k)) & 1) ? 2 : 1); ++rep_)
#define SEAM(k) do { if (IN(k) && IN((k) + 1)) GRID_BAR(); } while (0)
#define SEAM_L(k) do { if (IN(k) && IN((k) + 1)) LOCAL_BAR(); } while (0)
    const int cidx = (int)blockIdx.x;
    const int uidx = (C.G == 256) ? (cidx & 7) * 32 + (cidx >> 3) : cidx;
    const unsigned char* XN8 = WSP(unsigned char, WS_XN8); bf16_t* PROJ = WSP(bf16_t, WS_PROJ); bf16_t* CAT = WSP(bf16_t, WS_CAT);
    bf16_t* X = WSP(bf16_t, WS_XB);

    if (IN(0)) REPS(0) { p0_prologue(C, INF(16), INF(17), INF(18), INF(7), INF(8), INF(11), INF(14), INF(12), INF(9), INF(0), INF(3), INF(1), INF(5), (const int*)args.in[2], INF(10), INF(15)); } SEAM(0);
#if !MK_PER_PHASE
    if (IN(0) && IN(1)) { if (C.tid == 0) MISC[24] = xb_ld(&bar.bar[XB_BAD]); __syncthreads(); lok = __builtin_amdgcn_readfirstlane((int)MISC[24]) == 0; }
#endif
    if (IN(1)) REPS(1) {
        const bool part = (C.G == 256); const int q8 = cidx >> 3;
        const bool conv = part && ((q8 & 3) == 3);
        const int ci = (q8 >> 2) * 8 + (cidx & 7), gi = ((q8 >> 2) * 3 + (q8 & 3)) * 8 + (cidx & 7);
        pg8::ProbDense p{WSP(bf16_t, WS_XN), WSP(bf16_t, WS_WPIN), PROJ, 64, 8, DM, WSP(bf16_t, WS_MEMN), WSP(bf16_t, WS_WMEMKV), WSP(bf16_t, WS_MEMKV), 8, 8, DM, 32, DM, DM, part ? 192 : C.G, part ? (conv ? -1 : gi) : cidx};
        pg8::gemm_phase(C.lds, tab, p);
        { pg8::ProbFold pf{WSP(bf16_t, WS_WPOUT), WSP(bf16_t, WS_WGRP), WSP(bf16_t, WS_WPOUT2), 6, DM, 384, C.G, part ? (conv ? ci : -1) : (C.G >= 128 ? cidx - 64 : cidx)}; pg8::gemm_phase(C.lds, tab, pf); }
        if (part) { if (conv) expert_slot(C, ci * CONV1_N, CONV1_N, INF(16), INF(17), INF(18)); }
        else expert_items(IT_EXP - IT_MOVED + C.gw, C.NGW, IT_EXP - IT_MOVED + SLOT1_ITEMS, INF(16), INF(17), INF(18), C.ws, C.lane);
    } SEAM(1);
    if (IN(2)) REPS(2) {
        down_items((C.G == 256 ? 2 * C.NGW : 0) + C.gw, C.NGW, NE * 512, INF(18), C.ws, C.lane);
        for (int u = uidx; u < 256; u += C.G) xattn_unit<false, 2>(C, u, PROJ, DM, TOK, 0, C.gw + C.NGW < NE * 512 ? C.gw : 0, C.gw + C.NGW < NE * 512 ? C.NGW : 0, INF(18));
        pool_phase(C);
    } do { if (IN(2) && IN(4)) LOCAL_BAR(); } while (0);
    if (IN(4)) REPS(4) { pg8::ProbOut<true> p{CAT, WSP(bf16_t, WS_WPOUT2), WSP(bf16_t, WS_XN), X, WSP(float, WS_RINV), INF(3), 32, DM, DM, C.G, cidx}; pg8::gemm_phase(C.lds, tab, p); } SEAM_L(4);
#define MOE_PHASES(layer, pb) do { \
        if (IN(pb)) REPS(pb) { if (C.G == 256) router_phase_mfma(C, X, INF(4) + (layer) * DM, WSP(bf16_t, WS_WRT) + (size_t)(layer) * 2 * NE * DM); else router_phase(C, X, INF(4) + (layer) * DM, INF(15) + (size_t)(layer) * DM * NE); } SEAM_L(pb); \
        if (IN((pb) + 1)) REPS((pb) + 1) { rank_phase(C); } SEAM((pb) + 1); \
        if (IN((pb) + 2)) REPS((pb) + 2) { pg8::ProbGU p{WSP(unsigned char, WS_XN8), WSP(unsigned char, WS_WGU) + (size_t)(layer) * NE * DM * DM, WSP(int, WS_IDX), WSP(bf16_t, WS_HACT), 16, DM, DM, C.G, cidx}; pg8::gemm_phase(C.lds, tab, p); } SEAM_L((pb) + 2); \
        if (IN((pb) + 3)) REPS((pb) + 3) { pg8::ProbDN p{WSP(bf16_t, WS_HACT), (const bf16_t*)(WSP(unsigned char, WS_WDN) + (size_t)(layer) * NE * DM * DE), WSP(float, WS_IDX + 512 * 1024), WSP(bf16_t, WS_Y), 8, DE, DE, C.G, cidx}; pg8::gemm_phase(C.lds, tab, p); } SEAM((pb) + 3); \
    } while (0)
    MOE_PHASES(0, 5);
    if (IN(9)) { combine_phase<false>(C, X, INF(3) + DM, args.out); } SEAM_L(9);
    if (IN(10)) REPS(10) {
        const bool part = (C.G == 256); const int q8 = cidx >> 3;
        const bool conv = part && (q8 & 7) >= 5;
        const int ci = ((q8 >> 3) * 3 + (q8 & 7) - 5) * 8 + (cidx & 7), gi = ((q8 >> 3) * 5 + (q8 & 7)) * 8 + (cidx & 7);
        pg8::ProbDense8 p{XN8, WSP(unsigned char, WS_WAIN), PROJ, 64, 10, AINP, nullptr, nullptr, nullptr, 0, 0, 0, 16, DM, DM, part ? 160 : C.G, part ? (conv ? -1 : gi) : cidx};
        pg8::gemm_phase(C.lds, tab, p);
        if (part) { if (conv) { expert_slot(C, SLOT1_ITEMS + ci * CONV2_N, CONV2_N, INF(16), INF(17), INF(18)); down_items(NE * 512 + ci * DN10_N + C.wave, NWAVES, NE * 512 + (ci + 1) * DN10_N, INF(18), C.ws, C.lane); } }
        else expert_items(IT_EXP - IT_MOVED + SLOT1_ITEMS + C.gw, C.NGW, IT_EXP, INF(16), INF(17), INF(18), C.ws, C.lane);
    } SEAM_L(10);
    if (IN(11)) REPS(11) {
        if (C.G != 256) down_items(NE * 512 + C.gw, C.NGW, 2 * NE * 512, INF(18), C.ws, C.lane);
#pragma unroll 1
        for (int k = 0; k < 3; ++k) { const int u = uidx * 3 + k; int di = NE * 512 + DN10_ITEMS + C.gw + k * C.NGW; if (C.G != 256 || di >= 2 * NE * 512) di = 2 * NE * 512 - 1 - C.wave;
            if (u < 768) wattn_unit(C, u, INF(13), di, INF(18)); }
        if (C.G < 256) for (int u = C.G * 3 + cidx; u < 768; u += C.G) wattn_unit(C, u, INF(13), 2 * NE * 512 - 1 - C.wave, INF(18));
        { Ctx C2 = C; asm volatile("" : "+v"(C2.tid), "+v"(C2.lane));
          int dx = NE * 512 + DN10_ITEMS + C.gw + 3 * C.NGW; if (C.G != 256 || dx >= 2 * NE * 512) dx = 2 * NE * 512 - 1 - C.wave;
          for (int u = uidx; u < 256; u += C.G) xattn_unit<true, 1>(C2, u, PROJ, AINP, TOK + 2 * KVW, 1024, dx, 0, INF(18)); }
    } SEAM_L(11);
    if (IN(12)) { pg8::ProbOut8 p{WSP(unsigned char, WS_CAT), WSP(unsigned char, WS_WAOUT), X, 16, DM, DM, C.G, cidx}; pg8::gemm_phase(C.lds, tab, p); } SEAM_L(12);
    MOE_PHASES(1, 13);
    if (IN(17)) { combine_phase<true>(C, X, INF(6), args.out); }
#undef IN
#undef SEAM
#undef SEAM_L
}

extern "C" void kernel_launch(void* const* d_in, const int* in_sizes, int n_in, void* d_out, int out_size, void* d_ws, size_t ws_size, hipStream_t stream) {
    static int grid = 0;
    if (grid == 0) {
        if (n_in != 19 || out_size != M * DM || ws_size < WS_END) { fprintf(stderr, "kernel_launch: unexpected shapes (n_in %d, out %d, ws %zu < %zu); nothing launched\n", n_in, out_size, ws_size, (size_t)WS_END); grid = -1; return; }
        int dev = 0, cus = 0, per_cu = 0;
        if (hipGetDevice(&dev) != hipSuccess || hipDeviceGetAttribute(&cus, hipDeviceAttributeMultiprocessorCount, dev) != hipSuccess) { fprintf(stderr, "kernel_launch: device query failed\n"); grid = -1; return; }
        if (hipFuncSetAttribute((const void*)mk_fwd, hipFuncAttributeMaxDynamicSharedMemorySize, LDS_BYTES) != hipSuccess) { fprintf(stderr, "kernel_launch: hipFuncSetAttribute failed\n"); grid = -1; return; }
        if (hipOccupancyMaxActiveBlocksPerMultiprocessor(&per_cu, (const void*)mk_fwd, NTHR, LDS_BYTES) != hipSuccess || per_cu < 1)
            fprintf(stderr, "kernel_launch: note: occupancy query reports %d workgroups per CU\n", per_cu);
        (void)hipGetLastError();
        grid = cus;
        if (grid != 256) fprintf(stderr, "kernel_launch: note: %d CUs (tuned for 256)\n", grid);
    }
    if (grid < 0) return;
    if (hipMemsetAsync((char*)d_ws + WS_CTL, 0, CTL_ZERO_BYTES, stream) != hipSuccess) { fprintf(stderr, "kernel_launch: hipMemsetAsync failed\n"); return; }
    Args a{};
    for (int i = 0; i < 19; ++i) a.in[i] = d_in[i];
    a.out = (float*)d_out; a.ws = (unsigned char*)d_ws;
#if MK_PER_PHASE
    for (int ph = 0; ph < NPHASE; ++ph) { a.ph_lo = ph; a.ph_hi = ph + 1; hipLaunchKernelGGL(mk_fwd, dim3(grid), dim3(NTHR), LDS_BYTES, stream, a); }
#else
    a.ph_lo = 0; a.ph_hi = NPHASE;
    hipLaunchKernelGGL(mk_fwd, dim3(grid), dim3(NTHR), LDS_BYTES, stream, a);
#endif
    const hipError_t le = hipPeekAtLastError();
    if (le != hipSuccess) fprintf(stderr, "kernel_launch: launch failed: %s\n", hipGetErrorName(le));
}
```

```cpp
#include <hip/hip_runtime.h>
#include <cstdio>
#include <cstdint>

#ifndef MK_PER_PHASE
#define MK_PER_PHASE 0
#endif

#define LAS __attribute__((address_space(3)))
#define GAS __attribute__((address_space(1)))
typedef unsigned short bf16_t;
typedef short bf16x8 __attribute__((ext_vector_type(8)));
typedef short s16x4 __attribute__((ext_vector_type(4)));
typedef float f32x2 __attribute__((ext_vector_type(2)));
typedef float f32x4 __attribute__((ext_vector_type(4)));
typedef float f32x16 __attribute__((ext_vector_type(16)));
typedef unsigned u32x2 __attribute__((ext_vector_type(2)));
typedef unsigned u32x4 __attribute__((ext_vector_type(4)));
typedef __bf16 bf16x2_t __attribute__((ext_vector_type(2)));
typedef GAS unsigned gu32;

constexpr int NB = 8, SEQ = 2048, DM = 2048, M = NB * SEQ, MEML = 256, MR = NB * MEML;
constexpr int TOK = 1536, XAW = 512, KVW = 192, AIN = 2432, AINP = 2560;
constexpr int NE = 16, CAP = 256, DE = 1024, ER = NB * CAP;
constexpr float EPS = 1e-6f;
constexpr float LOG2E = 1.4426950408889634f;

constexpr size_t MiB = 1u << 20;
constexpr size_t WS_CTL = 0, CTL_ZERO_BYTES = 1 * MiB;
constexpr size_t WS_WMEMKV = 1 * MiB;
constexpr size_t WS_WPIN = 9 * MiB;
constexpr size_t WS_WPOUT = 17 * MiB;
constexpr size_t WS_WGRP = 25 * MiB;
constexpr size_t WS_WAIN = 27 * MiB;
constexpr size_t WS_WAOUT = 37 * MiB;
constexpr size_t WS_WGU = 45 * MiB;
constexpr size_t WS_XN8 = 173 * MiB;
constexpr size_t WS_WDN = 301 * MiB;
constexpr size_t WS_XN = 429 * MiB;
constexpr size_t WS_MEMN = 493 * MiB;
constexpr size_t WS_MEMKV = 501 * MiB;
constexpr size_t WS_PROJ = 509 * MiB;
constexpr size_t WS_WPOUT2 = 589 * MiB;
constexpr size_t WS_CAT = 637 * MiB;
constexpr size_t WS_HACT = 701 * MiB;
constexpr size_t WS_Y = 765 * MiB;
constexpr size_t WS_AFFT = 893 * MiB;
constexpr size_t WS_IDX = 894 * MiB;
constexpr size_t WS_WRT = 894 * MiB + 256 * 1024;
constexpr size_t WS_RINV = 894 * MiB + 768 * 1024;
constexpr size_t WS_SEL = 895 * MiB;
constexpr size_t WS_ROPE = 896 * MiB;
constexpr size_t WS_XB = 897 * MiB;
constexpr size_t WS_END = 961 * MiB;
constexpr int CW_BAR = 4096;

constexpr int RING_BYTES = 143360;
constexpr int TAB_OFF = RING_BYTES;
constexpr int MISC_OFF = TAB_OFF + 8192;
constexpr int LDS_BYTES = MISC_OFF + 256;
constexpr int NWAVES = 8, NTHR = 512;

#define LDS_WAIT() asm volatile("s_waitcnt lgkmcnt(0)" ::: "memory")
#define VM_WAIT() asm volatile("s_waitcnt vmcnt(0)" ::: "memory")
__device__ __forceinline__ float bf2f(bf16_t v) { return __uint_as_float(((unsigned)v) << 16); }
__device__ __forceinline__ unsigned pk2(float lo, float hi) { f32x2 v = {lo, hi}; bf16x2_t b = __builtin_convertvector(v, bf16x2_t); return __builtin_bit_cast(unsigned, b); }
__device__ __forceinline__ bf16_t f2bf(float f) { return (bf16_t)(pk2(f, 0.f) & 0xffffu); }
__device__ __forceinline__ float lo16(unsigned w) { return __uint_as_float(w << 16); }
__device__ __forceinline__ float hi16(unsigned w) { return __uint_as_float(w & 0xffff0000u); }
constexpr float Y_SCALE = 32.0f, Y_INV = 1.0f / 32.0f;
constexpr float SC_CAT = 16.0f, SC_WD8 = 64.0f;
__device__ __forceinline__ unsigned pk4_fp8(float a, float b, float c, float d) {
    a = __builtin_amdgcn_fmed3f(a, -448.f, 448.f); b = __builtin_amdgcn_fmed3f(b, -448.f, 448.f); c = __builtin_amdgcn_fmed3f(c, -448.f, 448.f); d = __builtin_amdgcn_fmed3f(d, -448.f, 448.f);
    int w = __builtin_amdgcn_cvt_pk_fp8_f32(a, b, 0, false); w = __builtin_amdgcn_cvt_pk_fp8_f32(c, d, w, true); return (unsigned)w;
}
__device__ __forceinline__ f32x4 up4_fp8(unsigned w) { const f32x2 lo = __builtin_amdgcn_cvt_pk_f32_fp8((int)w, false), hi = __builtin_amdgcn_cvt_pk_f32_fp8((int)w, true); return (f32x4){lo.x, lo.y, hi.x, hi.y}; }
__device__ __forceinline__ float wave_sum(float v) {
#pragma unroll
    for (int o = 1; o < 64; o <<= 1) v += __shfl_xor(v, o);
    return v;
}
__device__ __forceinline__ int crow(int r, int hi) { return (r & 3) + 8 * (r >> 2) + 4 * hi; }

#define XB_TMO      128
#define XB_XCNT(j)  (256  + 64 * (j))
#define XB_XSUB(j)  (1280 + 64 * (j))
#define XB_XGEN(j)  (2304 + 64 * (j))
#define XB_TOP      3328
#define XB_TOPGEN   3392
#define XCD_BAR_WORDS 3456
#define XB_SPIN_CAP (1u << 18)
__device__ __forceinline__ unsigned xb_ld(unsigned* p)              { return __hip_atomic_load(p, __ATOMIC_RELAXED, __HIP_MEMORY_SCOPE_AGENT); }
__device__ __forceinline__ unsigned xb_add(unsigned* p, unsigned v) { return __hip_atomic_fetch_add(p, v, __ATOMIC_RELAXED, __HIP_MEMORY_SCOPE_AGENT); }
__device__ __forceinline__ unsigned xb_xcc_id() { return (unsigned)__builtin_amdgcn_s_getreg((3 << 11) | 20) & 0xFu; }
#define XB_SPIN(cond, bar) do { unsigned _sp = 0; while (cond) { __builtin_amdgcn_s_sleep(1); \
    if ((++_sp & 255u) == 0u) { if (xb_ld(&(bar)[XB_TMO])) break; if (_sp > XB_SPIN_CAP) { atomicAdd(&(bar)[XB_TMO], 1u); break; } } } } while (0)
struct XcdBarrier { unsigned* bar; unsigned x; volatile LAS unsigned* st; };
__device__ __forceinline__ XcdBarrier xcd_barrier_post(unsigned* bar, volatile LAS unsigned* st) {
    XcdBarrier b; b.bar = bar; b.x = xb_xcc_id(); b.st = st;
    if (threadIdx.x == 0) (void)xb_add(&bar[XB_XCNT(b.x)], 1u);
    return b;
}
__device__ __forceinline__ void xcd_barrier_complete(unsigned* bar, unsigned x, unsigned& nloc, unsigned& nx) {
    const unsigned G = gridDim.x * gridDim.y * gridDim.z;
    unsigned sum, cnt, mine, sp = 0u;
    for (;;) {
        sum = 0u; cnt = 0u; mine = 0u;
#pragma unroll
        for (unsigned j = 0; j < 16; ++j) { const unsigned c = xb_ld(&bar[XB_XCNT(j)]); sum += c; cnt += (c > 0u) ? 1u : 0u; mine = (j == x) ? c : mine; }
        if (sum == G) break;
        __builtin_amdgcn_s_sleep(1);
        if ((++sp & 255u) == 0u) { if (xb_ld(&bar[XB_TMO])) break; if (sp > XB_SPIN_CAP) { atomicAdd(&bar[XB_TMO], 1u); break; } }
    }
    nloc = mine > 0u ? mine : 1u; nx = cnt > 0u ? cnt : 1u;
}
__device__ __forceinline__ void xcd_barrier(const XcdBarrier& b) {
    asm volatile("s_waitcnt vmcnt(0)" ::: "memory");
    __syncthreads();
    if (threadIdx.x == 0) {
        unsigned* bar = b.bar;
        __builtin_amdgcn_s_waitcnt(0);
        unsigned nloc = b.st[0], nx = b.st[1];
        if (nloc == 0u) { xcd_barrier_complete(bar, b.x, nloc, nx); b.st[0] = nloc; b.st[1] = nx; }
        const unsigned old = xb_add(&bar[XB_XSUB(b.x)], 1u);
        const unsigned gen = old / nloc;
        if (old + 1u == (gen + 1u) * nloc) {
            __builtin_amdgcn_fence(__ATOMIC_RELEASE, "agent");
            asm volatile("s_waitcnt vmcnt(0)" ::: "memory");
            const unsigned og = xb_add(&bar[XB_TOP], 1u);
            const unsigned tg = og / nx;
            if (og + 1u == (tg + 1u) * nx) xb_add(&bar[XB_TOPGEN], 1u);
            else XB_SPIN(xb_ld(&bar[XB_TOPGEN]) == tg, bar);
            __builtin_amdgcn_fence(__ATOMIC_ACQUIRE, "agent");
            xb_add(&bar[XB_XGEN(b.x)], 1u);
            asm volatile("s_waitcnt vmcnt(0)" ::: "memory");
        } else {
            XB_SPIN(xb_ld(&bar[XB_XGEN(b.x)]) == gen, bar);
            __builtin_amdgcn_fence(__ATOMIC_ACQUIRE, "agent");
            asm volatile("s_waitcnt vmcnt(0)" ::: "memory");
        }
    }
    __syncthreads();
}

#define XB_LCNT(j)  (4096 + 64 * (j))
#define XB_BAD      6144
__device__ __forceinline__ void xcd_local_barrier(const XcdBarrier& b, unsigned target) {
    asm volatile("s_waitcnt vmcnt(0)" ::: "memory");
    __syncthreads();
    if (threadIdx.x == 0) {
        unsigned* bar = b.bar;
        __builtin_amdgcn_s_waitcnt(0);
        (void)xb_add(&bar[XB_LCNT(b.x)], 1u);
        XB_SPIN(xb_ld(&bar[XB_LCNT(b.x)]) < target, bar);
        __builtin_amdgcn_fence(__ATOMIC_ACQUIRE, "agent");
        asm volatile("s_waitcnt vmcnt(0)" ::: "memory");
    }
    __syncthreads();
}

namespace pg8 {
constexpr int BM = 256, BK = 64, HALF = 128, HTB = HALF * BK * 2;
__device__ __forceinline__ int lds_byte(int r, int c) { const int st = (r >> 4) * 2 + (c >> 5), rr = r & 15, cc = c & 31, ob = rr * 64 + cc * 2; return st * 1024 + (ob ^ (((ob >> 9) & 1) << 5)); }
__device__ __forceinline__ void stage_rc(int b, int& R, int& C) { const int st = b / 1024, sb = b % 1024, swz = sb ^ (((sb >> 9) & 1) << 5); R = (st >> 1) * 16 + swz / 64; C = (st & 1) * 32 + (swz % 64) / 2; }
__device__ __forceinline__ int perm32(int rho) { const int n = rho >> 4, i = rho & 15; return 8 * (i >> 2) + 4 * n + (i & 3); }
struct Unit { int pm, pn, e; };
typedef int i32x8 __attribute__((ext_vector_type(8)));
typedef int i32x4 __attribute__((ext_vector_type(4)));
__device__ __forceinline__ i32x8 cat8(bf16x8 a, bf16x8 b) { const i32x4 x = __builtin_bit_cast(i32x4, a), y = __builtin_bit_cast(i32x4, b); return (i32x8){x[0], x[1], x[2], x[3], y[0], y[1], y[2], y[3]}; }
typedef f32x4 Acc[2][2][4][2];
__device__ __forceinline__ void xcd_tile(int L, int nM, int nN, int& pm, int& pn) {
    const int nwg = nM * nN; int wgid = L; { const int q = nwg / 8, r = nwg % 8, xcd = wgid % 8, off = wgid / 8; wgid = (xcd < r ? xcd * (q + 1) : r * (q + 1) + (xcd - r) * q) + off; }
    const int nig = 8 * nN, gid = wgid / nig, fm = gid * 8, gsz = (nM - fm) < 8 ? (nM - fm) : 8;
    pm = fm + ((wgid % nig) % gsz); pn = (wgid % nig) / gsz;
}

template <class P>
__device__ __forceinline__ void gemm_phase(LAS unsigned char* lds, LAS int* tab, const P& p) {
    const int tid = threadIdx.x, wid = __builtin_amdgcn_readfirstlane(tid >> 6), lane = tid & 63, wr = wid >> 2, wc = wid & 3, fr = lane & 15, fq = lane >> 4;
    const int nt = p.nt;
    Unit cur, nxt; int ui = 0;
    if (!p.next(0, cur)) return;
    if constexpr (P::GATHER) { Unit tu; for (int i = 0; p.next(i, tu); ++i) p.fill_tab(tab, i, tu, tid); LDS_WAIT(); __syncthreads(); }
    int R_[2], C_[2]; unsigned voffB[2];
#pragma unroll
    for (int i = 0; i < 2; ++i) { int R, C; stage_rc(tid * 16 + i * 8192, R, C); R_[i] = R; C_[i] = C; const int Rb = P::PERM ? ((R & ~31) + perm32(R & 31)) : R; voffB[i] = (unsigned)(Rb * p.ldb) * (unsigned)P::ESZ + (unsigned)C * 2u; }
    unsigned voffA0[2], voffA1[2];
#define PG8_SETA(U, UI) do { if constexpr (P::GATHER_A) { _Pragma("unroll") for (int _i = 0; _i < 2; ++_i) { voffA0[_i] = p.a_rowoff(U, UI, R_[_i], tab) + (unsigned)C_[_i] * 2u; voffA1[_i] = p.a_rowoff(U, UI, R_[_i] + HALF, tab) + (unsigned)C_[_i] * 2u; } } } while (0)
    if constexpr (P::GATHER_A) { PG8_SETA(cur, 0); }
    else { _Pragma("unroll") for (int _i = 0; _i < 2; ++_i) { voffA0[_i] = p.a_rowoff(cur, 0, R_[_i], tab) + (unsigned)C_[_i] * 2u; voffA1[_i] = voffA0[_i]; } }
    const size_t hstepA = P::GATHER_A ? (size_t)0 : (size_t)p.a_rowoff(cur, 0, HALF, tab);
    const size_t kstep = (size_t)(BK * 2), hstepB = (size_t)HALF * p.ldb * P::ESZ;
    const unsigned ldsw = (unsigned)wid * 1024u;
    const int aoff = lds_byte(wr * 64 + fr, fq * 8), boff = lds_byte(wc * 32 + fr, fq * 8);
#define PG8_SA(b, h) (((b) * 2 + (h)) * HTB)
#define PG8_SB(b, h) ((4 + (b) * 2 + (h)) * HTB)
#define PG8_STAGE(bufoff, gbase, voff) do { _Pragma("unroll") for (int _i = 0; _i < 2; ++_i) \
        __builtin_amdgcn_global_load_lds((const unsigned*)((const char*)(gbase) + (voff)[_i]), (LAS unsigned*)(lds + (bufoff) + ldsw + _i * 8192), 16, 0, 0); } while (0)
#define PG8_LDA(dst, b, h) do { _Pragma("unroll") for (int m = 0; m < 4; ++m) _Pragma("unroll") for (int k = 0; k < 2; ++k) dst[m][k] = *(const LAS bf16x8*)(lds + PG8_SA(b, h) + aoff + m * 2048 + k * 1024); } while (0)
#define PG8_LDB(dst, b, h) do { _Pragma("unroll") for (int n = 0; n < 2; ++n) _Pragma("unroll") for (int k = 0; k < 2; ++k) dst[n][k] = *(const LAS bf16x8*)(lds + PG8_SB(b, h) + boff + n * 2048 + k * 1024); } while (0)
#define PG8_MMA(ai, bj, At, Bt) do { __builtin_amdgcn_s_setprio(1); \
        if constexpr (P::ESZ == 2) { _Pragma("unroll") for (int m = 0; m < 4; ++m) _Pragma("unroll") for (int n = 0; n < 2; ++n) _Pragma("unroll") for (int k = 0; k < 2; ++k) \
            acc[ai][bj][m][n] = __builtin_amdgcn_mfma_f32_16x16x32_bf16(Bt[n][k], At[m][k], acc[ai][bj][m][n], 0, 0, 0); } \
        else { _Pragma("unroll") for (int m = 0; m < 4; ++m) _Pragma("unroll") for (int n = 0; n < 2; ++n) \
            acc[ai][bj][m][n] = __builtin_amdgcn_mfma_scale_f32_16x16x128_f8f6f4(cat8(Bt[n][0], Bt[n][1]), cat8(At[m][0], At[m][1]), acc[ai][bj][m][n], 0, 0, 0, 0x7F7F7F7F, 0, 0x7F7F7F7F); } \
        __builtin_amdgcn_s_setprio(0); } while (0)
#define PG8_WAIT_V(n) asm volatile("s_waitcnt vmcnt(" #n ")" ::: "memory")
#define PG8_WAIT_L(n) asm volatile("s_waitcnt lgkmcnt(" #n ")" ::: "memory")
#define PG8_BAR __builtin_amdgcn_s_barrier()
#define PG8_SCHED __builtin_amdgcn_sched_barrier(0)
    Acc acc;
#pragma unroll
    for (int a = 0; a < 2; ++a)
#pragma unroll
        for (int b = 0; b < 2; ++b)
#pragma unroll
            for (int m = 0; m < 4; ++m)
#pragma unroll
                for (int n = 0; n < 2; ++n) acc[a][b][m][n] = (f32x4){0.f, 0.f, 0.f, 0.f};
    bf16x8 At[4][2], B0[2][2], B1[2][2];
    const char* cA = p.a_base(cur); const char* cB = p.b_base(cur);
    PG8_STAGE(PG8_SB(0, 0), cB, voffB); PG8_STAGE(PG8_SB(0, 1), cB + hstepB, voffB); PG8_STAGE(PG8_SA(0, 0), cA, voffA0); PG8_STAGE(PG8_SA(0, 1), cA + hstepA, voffA1);
    if (wr == 1) PG8_BAR;
    PG8_WAIT_V(2); PG8_BAR;
    PG8_STAGE(PG8_SB(1, 0), cB + kstep, voffB); PG8_STAGE(PG8_SA(1, 0), cA + kstep, voffA0); PG8_STAGE(PG8_SB(1, 1), cB + hstepB + kstep, voffB);
    PG8_WAIT_V(6); PG8_BAR;
    for (;;) {
        const bool has_next = p.next(ui + 1, nxt);
        const char* nA = has_next ? p.a_base(nxt) : cA; const char* nB = has_next ? p.b_base(nxt) : cB;
#pragma unroll 1
        for (int t = 0; t < nt; t += 2) {
            const bool last = (t == nt - 2);
            const char* a1 = cA + (size_t)(t + 1) * kstep;
            const char* a2 = last ? nA : cA + (size_t)(t + 2) * kstep; const char* b2 = last ? nB : cB + (size_t)(t + 2) * kstep;
            const char* a3 = a2 + kstep; const char* b3 = b2 + kstep;
            PG8_LDB(B0, 0, 0); PG8_LDB(B1, 0, 1); PG8_SCHED; PG8_LDA(At, 0, 0); PG8_STAGE(PG8_SA(1, 1), a1 + hstepA, voffA1);
            if (last && has_next) { PG8_SETA(nxt, ui + 1); }
            PG8_WAIT_V(8); PG8_WAIT_L(0); PG8_BAR; PG8_MMA(0, 0, At, B0); PG8_MMA(0, 1, At, B1); PG8_BAR; PG8_SCHED;
            PG8_LDA(At, 0, 1); PG8_STAGE(PG8_SB(0, 0), b2, voffB); PG8_STAGE(PG8_SB(0, 1), b2 + hstepB, voffB); PG8_STAGE(PG8_SA(0, 0), a2, voffA0);
            PG8_WAIT_V(8); PG8_WAIT_L(0); PG8_BAR; PG8_MMA(1, 0, At, B0); PG8_MMA(1, 1, At, B1); PG8_BAR; PG8_SCHED;
            PG8_LDB(B0, 1, 0); PG8_LDB(B1, 1, 1); PG8_SCHED; PG8_LDA(At, 1, 0); PG8_STAGE(PG8_SA(0, 1), a2 + hstepA, voffA1);
            PG8_WAIT_V(8); PG8_WAIT_L(0); PG8_BAR; PG8_MMA(0, 0, At, B0); PG8_MMA(0, 1, At, B1); PG8_BAR; PG8_SCHED;
            PG8_LDA(At, 1, 1); PG8_STAGE(PG8_SB(1, 0), b3, voffB); PG8_STAGE(PG8_SB(1, 1), b3 + hstepB, voffB); PG8_STAGE(PG8_SA(1, 0), a3, voffA0);
            PG8_WAIT_V(8); PG8_WAIT_L(0); PG8_BAR; PG8_MMA(1, 0, At, B0); PG8_MMA(1, 1, At, B1); PG8_BAR; PG8_SCHED;
        }
        if (wr == 0) PG8_BAR;
        { int fr_ = fr, fq_ = fq; asm volatile("" : "+v"(fr_), "+v"(fq_));
          p.epi(acc, cur, ui, tab, wr, wc, fr_, fq_); }
        if (!has_next) break;
#pragma unroll
        for (int a = 0; a < 2; ++a)
#pragma unroll
            for (int b = 0; b < 2; ++b)
#pragma unroll
                for (int m = 0; m < 4; ++m)
#pragma unroll
                    for (int n = 0; n < 2; ++n) acc[a][b][m][n] = (f32x4){0.f, 0.f, 0.f, 0.f};
        cur = nxt; cA = nA; cB = nB; ++ui;
        if (wr == 1) PG8_BAR;
    }
    PG8_WAIT_V(0);
    PG8_BAR;
#undef PG8_SETA
#undef PG8_SA
#undef PG8_SB
#undef PG8_STAGE
#undef PG8_LDA
#undef PG8_LDB
#undef PG8_MMA
#undef PG8_WAIT_V
#undef PG8_WAIT_L
#undef PG8_BAR
#undef PG8_SCHED
}

struct ProbDense8 {
    static constexpr bool PERM = true, GATHER = false, GATHER_A = true; static constexpr int ESZ = 1;
    const unsigned char* A; const unsigned char* Bt; bf16_t* O; int nM, nN, ldo;
    const unsigned char* A2; const unsigned char* Bt2; bf16_t* O2; int nM2, nN2, ldo2;
    int nt, lda, ldb, G, c;
    __device__ __forceinline__ bool next(int i, Unit& u) const {
        if (c < 0) return false;
        int L = i * G + c; const int n1 = nM * nN;
        if (L < n1) { xcd_tile(L, nM, nN, u.pm, u.pn); u.e = 0; return true; }
        L -= n1; if (L >= nM2 * nN2) return false;
        xcd_tile(L, nM2, nN2, u.pm, u.pn); u.e = 1; return true;
    }
    __device__ __forceinline__ const char* a_base(const Unit& u) const { return (const char*)(u.e ? A2 : A); }
    __device__ __forceinline__ const char* b_base(const Unit& u) const { return (const char*)(u.e ? Bt2 : Bt) + (size_t)u.pn * BM * ldb; }
    __device__ __forceinline__ unsigned a_rowoff(const Unit& u, int, int r, LAS int*) const { return (unsigned)((u.pm * BM + r) * lda); }
    __device__ __forceinline__ void fill_tab(LAS int*, int, const Unit&, int) const {}
    __device__ __forceinline__ void epi(const Acc& acc, const Unit& u, int, LAS int*, int wr, int wc, int fr, int fq) const {
        bf16_t* o = u.e ? O2 : O; const int ld = u.e ? ldo2 : ldo;
        const int row0 = u.pm * BM + wr * 64 + fr, col0 = u.pn * BM + wc * 32 + 8 * fq;
        constexpr float inv = 1.0f / (8.0f * 64.0f);
#pragma unroll
        for (int ai = 0; ai < 2; ++ai)
#pragma unroll
            for (int m = 0; m < 4; ++m) { bf16_t* rowp = o + (size_t)(row0 + ai * HALF + m * 16) * ld + col0;
#pragma unroll
                for (int bj = 0; bj < 2; ++bj) { const f32x4 v0 = acc[ai][bj][m][0] * inv, v1 = acc[ai][bj][m][1] * inv;
                    u32x4 w; w.x = pk2(v0[0], v0[1]); w.y = pk2(v0[2], v0[3]); w.z = pk2(v1[0], v1[1]); w.w = pk2(v1[2], v1[3]);
                    *(u32x4*)(rowp + bj * HALF) = w; } }
    }
};
struct ProbDense {
    static constexpr bool PERM = true, GATHER = false, GATHER_A = false; static constexpr int ESZ = 2;
    const bf16_t* A; const bf16_t* Bt; bf16_t* O; int nM, nN, ldo;
    const bf16_t* A2; const bf16_t* Bt2; bf16_t* O2; int nM2, nN2, ldo2;
    int nt, lda, ldb, G, c;
    __device__ __forceinline__ bool next(int i, Unit& u) const {
        if (c < 0) return false;
        int L = i * G + c; const int n1 = nM * nN;
        if (L < n1) { xcd_tile(L, nM, nN, u.pm, u.pn); u.e = 0; return true; }
        L -= n1; if (L >= nM2 * nN2) return false;
        xcd_tile(L, nM2, nN2, u.pm, u.pn); u.e = 1; return true;
    }
    __device__ __forceinline__ const char* a_base(const Unit& u) const { return (const char*)(u.e ? A2 : A) + (size_t)u.pm * BM * lda * 2; }
    __device__ __forceinline__ const char* b_base(const Unit& u) const { return (const char*)(u.e ? Bt2 : Bt) + (size_t)u.pn * BM * ldb * 2; }
    __device__ __forceinline__ unsigned a_rowoff(const Unit&, int, int r, LAS int*) const { return (unsigned)(r * lda) * 2u; }
    __device__ __forceinline__ void fill_tab(LAS int*, int, const Unit&, int) const {}
    __device__ __forceinline__ void epi(const Acc& acc, const Unit& u, int, LAS int*, int wr, int wc, int fr, int fq) const {
        bf16_t* o = u.e ? O2 : O; const int ld = u.e ? ldo2 : ldo;
        const int row0 = u.pm * BM + wr * 64 + fr, col0 = u.pn * BM + wc * 32 + 8 * fq;
#pragma unroll
        for (int ai = 0; ai < 2; ++ai)
#pragma unroll
            for (int m = 0; m < 4; ++m) { bf16_t* rowp = o + (size_t)(row0 + ai * HALF + m * 16) * ld + col0;
#pragma unroll
                for (int bj = 0; bj < 2; ++bj) { const f32x4 v0 = acc[ai][bj][m][0], v1 = acc[ai][bj][m][1];
                    u32x4 w; w.x = pk2(v0[0], v0[1]); w.y = pk2(v0[2], v0[3]); w.z = pk2(v1[0], v1[1]); w.w = pk2(v1[2], v1[3]);
                    *(u32x4*)(rowp + bj * HALF) = w; } }
    }
};
template <bool RF32>
struct ProbOut {
    static constexpr bool PERM = true, GATHER = false, GATHER_A = false; static constexpr int ESZ = 2;
    const bf16_t* A; const bf16_t* Bt; const void* R; bf16_t* X; const float* RS; const float* Gn;
    int nt, lda, ldb, G, c;
    __device__ __forceinline__ bool next(int i, Unit& u) const { const int L = i * G + c; if (L >= 64 * 8) return false; xcd_tile(L, 64, 8, u.pm, u.pn); u.e = 0; return true; }
    __device__ __forceinline__ const char* a_base(const Unit& u) const { return (const char*)A + (size_t)u.pm * BM * lda * 2; }
    __device__ __forceinline__ const char* b_base(const Unit& u) const { return (const char*)Bt + (size_t)u.pn * BM * ldb * 2; }
    __device__ __forceinline__ unsigned a_rowoff(const Unit&, int, int r, LAS int*) const { return (unsigned)(r * lda) * 2u; }
    __device__ __forceinline__ void fill_tab(LAS int*, int, const Unit&, int) const {}
    __device__ __forceinline__ void epi(const Acc& acc, const Unit& u, int, LAS int*, int wr, int wc, int fr, int fq) const {
        const int row0 = u.pm * BM + wr * 64 + fr, col0 = u.pn * BM + wc * 32 + 8 * fq;
        f32x4 gi[2][2];
        if constexpr (RF32) {
#pragma unroll
            for (int bj = 0; bj < 2; ++bj)
#pragma unroll
                for (int q = 0; q < 2; ++q) { const f32x4 gv = *(const f32x4*)(Gn + col0 + bj * HALF + 4 * q); gi[bj][q] = (f32x4){1.0f / gv.x, 1.0f / gv.y, 1.0f / gv.z, 1.0f / gv.w}; }
        }
#pragma unroll
        for (int ai = 0; ai < 2; ++ai) {
            if constexpr (RF32) {
                u32x4 rv[4][2]; float rs[4];
#pragma unroll
                for (int m = 0; m < 4; ++m) { const bf16_t* rp = (const bf16_t*)R + (size_t)(row0 + ai * HALF + m * 16) * DM + col0; rs[m] = RS[row0 + ai * HALF + m * 16];
#pragma unroll
                    for (int bj = 0; bj < 2; ++bj) rv[m][bj] = *(const u32x4*)(rp + bj * HALF); }
                asm volatile("" ::: "memory");
#pragma unroll
                for (int m = 0; m < 4; ++m) { bf16_t* xp = X + (size_t)(row0 + ai * HALF + m * 16) * DM + col0;
#pragma unroll
                    for (int bj = 0; bj < 2; ++bj) { const u32x4 r = rv[m][bj]; const f32x4 q0 = gi[bj][0] * rs[m], q1 = gi[bj][1] * rs[m];
                        const f32x4 v0 = (f32x4){lo16(r.x), hi16(r.x), lo16(r.y), hi16(r.y)} * q0 + acc[ai][bj][m][0], v1 = (f32x4){lo16(r.z), hi16(r.z), lo16(r.w), hi16(r.w)} * q1 + acc[ai][bj][m][1];
                        u32x4 w; w.x = pk2(v0[0], v0[1]); w.y = pk2(v0[2], v0[3]); w.z = pk2(v1[0], v1[1]); w.w = pk2(v1[2], v1[3]);
                        *(u32x4*)(xp + bj * HALF) = w; } }
            } else {
                u32x4 rv[4][2];
#pragma unroll
                for (int m = 0; m < 4; ++m) { const bf16_t* rp = (const bf16_t*)R + (size_t)(row0 + ai * HALF + m * 16) * DM + col0;
#pragma unroll
                    for (int bj = 0; bj < 2; ++bj) rv[m][bj] = *(const u32x4*)(rp + bj * HALF); }
                asm volatile("" ::: "memory");
#pragma unroll
                for (int m = 0; m < 4; ++m) { bf16_t* xp = X + (size_t)(row0 + ai * HALF + m * 16) * DM + col0;
#pragma unroll
                    for (int bj = 0; bj < 2; ++bj) { const f32x4 a0 = acc[ai][bj][m][0], a1 = acc[ai][bj][m][1]; const u32x4 r = rv[m][bj];
                        u32x4 w; w.x = pk2(lo16(r.x) + a0[0], hi16(r.x) + a0[1]); w.y = pk2(lo16(r.y) + a0[2], hi16(r.y) + a0[3]);
                        w.z = pk2(lo16(r.z) + a1[0], hi16(r.z) + a1[1]); w.w = pk2(lo16(r.w) + a1[2], hi16(r.w) + a1[3]);
                        *(u32x4*)(xp + bj * HALF) = w; } }
            }
            asm volatile("" ::: "memory");
        }
    }
};
struct ProbOut8 {
    static constexpr bool PERM = true, GATHER = false, GATHER_A = true; static constexpr int ESZ = 1;
    const unsigned char* A; const unsigned char* Bt; bf16_t* X;
    int nt, lda, ldb, G, c;
    __device__ __forceinline__ bool next(int i, Unit& u) const { const int L = i * G + c; if (L >= 64 * 8) return false; xcd_tile(L, 64, 8, u.pm, u.pn); u.e = 0; return true; }
    __device__ __forceinline__ const char* a_base(const Unit&) const { return (const char*)A; }
    __device__ __forceinline__ const char* b_base(const Unit& u) const { return (const char*)Bt + (size_t)u.pn * BM * ldb; }
    __device__ __forceinline__ unsigned a_rowoff(const Unit& u, int, int r, LAS int*) const { return (unsigned)((u.pm * BM + r) * lda); }
    __device__ __forceinline__ void fill_tab(LAS int*, int, const Unit&, int) const {}
    __device__ __forceinline__ void epi(const Acc& acc, const Unit& u, int, LAS int*, int wr, int wc, int fr, int fq) const {
        const int row0 = u.pm * BM + wr * 64 + fr, col0 = u.pn * BM + wc * 32 + 8 * fq;
        constexpr float inv = 1.0f / (16.0f * 64.0f);
#pragma unroll
        for (int ai = 0; ai < 2; ++ai) {
            u32x4 rv[4][2];
#pragma unroll
            for (int m = 0; m < 4; ++m) { const bf16_t* rp = X + (size_t)(row0 + ai * HALF + m * 16) * DM + col0;
#pragma unroll
                for (int bj = 0; bj < 2; ++bj) rv[m][bj] = *(const u32x4*)(rp + bj * HALF); }
            asm volatile("" ::: "memory");
#pragma unroll
            for (int m = 0; m < 4; ++m) { bf16_t* xp = X + (size_t)(row0 + ai * HALF + m * 16) * DM + col0;
#pragma unroll
                for (int bj = 0; bj < 2; ++bj) { const f32x4 a0 = acc[ai][bj][m][0] * inv, a1 = acc[ai][bj][m][1] * inv; const u32x4 r = rv[m][bj];
                    u32x4 w; w.x = pk2(lo16(r.x) + a0[0], hi16(r.x) + a0[1]); w.y = pk2(lo16(r.y) + a0[2], hi16(r.y) + a0[3]);
                    w.z = pk2(lo16(r.z) + a1[0], hi16(r.z) + a1[1]); w.w = pk2(lo16(r.w) + a1[2], hi16(r.w) + a1[3]);
                    *(u32x4*)(xp + bj * HALF) = w; } }
            asm volatile("" ::: "memory");
        }
    }
};
struct ProbFold {
    static constexpr bool PERM = true, GATHER = false, GATHER_A = false; static constexpr int ESZ = 2;
    const bf16_t* A; const bf16_t* Bt; bf16_t* O;
    int nt, lda, ldb, G, c;
    __device__ __forceinline__ bool next(int i, Unit& u) const { if (i != 0 || c < 0 || c >= 64) return false; u.pm = c & 7; u.e = c >> 3; u.pn = 0; return true; }
    __device__ __forceinline__ const char* a_base(const Unit& u) const { return (const char*)A + ((size_t)u.pm * BM * lda + (size_t)(u.e >> 1) * 384) * 2; }
    __device__ __forceinline__ const char* b_base(const Unit& u) const { return (const char*)Bt + (size_t)u.e * BM * ldb * 2; }
    __device__ __forceinline__ unsigned a_rowoff(const Unit&, int, int r, LAS int*) const { return (unsigned)(r * lda) * 2u; }
    __device__ __forceinline__ void fill_tab(LAS int*, int, const Unit&, int) const {}
    __device__ __forceinline__ void epi(const Acc& acc, const Unit& u, int, LAS int*, int wr, int wc, int fr, int fq) const {
        const int g = u.e >> 1, hh = u.e & 1;
        const int row0 = u.pm * BM + wr * 64 + fr;
#pragma unroll
        for (int bj = 0; bj < 2; ++bj) {
            if (hh && bj) continue;
            const int col = g * 384 + hh * 256 + bj * HALF + wc * 32 + 8 * fq;
#pragma unroll
            for (int ai = 0; ai < 2; ++ai)
#pragma unroll
                for (int m = 0; m < 4; ++m) { const f32x4 v0 = acc[ai][bj][m][0], v1 = acc[ai][bj][m][1];
                    u32x4 w; w.x = pk2(v0[0], v0[1]); w.y = pk2(v0[2], v0[3]); w.z = pk2(v1[0], v1[1]); w.w = pk2(v1[2], v1[3]);
                    *(u32x4*)(O + (size_t)(row0 + ai * HALF + m * 16) * DM + col) = w; }
        }
    }
};
__device__ __forceinline__ float silu_f(float g) { return g * __builtin_amdgcn_rcpf(1.0f + __builtin_amdgcn_exp2f(-g * LOG2E)); }
constexpr float SC_X = 8.0f, SC_WGU = 64.0f, SC_H = 16.0f, SC_WDN = 32.0f;
struct ProbGU {
    static constexpr bool PERM = true, GATHER = true, GATHER_A = true; static constexpr int ESZ = 1;
    const unsigned char* A; const unsigned char* Bt; const int* IDX; bf16_t* O;
    int nt, lda, ldb, G, c;
    __device__ __forceinline__ bool next(int i, Unit& u) const { const int L = i * G + c; if (L >= 1024) return false; const int wg = (L % 8) * 128 + L / 8; u.e = wg / 64; const int w = wg % 64; u.pm = w % 8; u.pn = w / 8; return true; }
    __device__ __forceinline__ const char* a_base(const Unit&) const { return (const char*)A; }
    __device__ __forceinline__ const char* b_base(const Unit& u) const { return (const char*)Bt + (size_t)(u.e * 8 + u.pn) * BM * ldb; }
    __device__ __forceinline__ unsigned a_rowoff(const Unit&, int ui, int r, LAS int* tab) const { return (unsigned)tab[ui * 256 + r] * (unsigned)DM; }
    __device__ __forceinline__ void fill_tab(LAS int* tab, int ui, const Unit& u, int tid) const { if (tid < 256 && ui < 8) tab[ui * 256 + tid] = IDX[(u.e * 8 + u.pm) * 256 + tid]; }
    __device__ __forceinline__ void epi(const Acc& acc, const Unit& u, int, LAS int*, int wr, int wc, int fr, int fq) const {
        const int row0 = u.e * ER + u.pm * BM + wr * 64 + fr, col0 = u.pn * HALF + wc * 32 + 8 * fq;
        constexpr float inv = 1.0f / (SC_X * SC_WGU);
#pragma unroll
        for (int ai = 0; ai < 2; ++ai)
#pragma unroll
            for (int m = 0; m < 4; ++m) { const f32x4 g0 = acc[ai][0][m][0] * inv, g1 = acc[ai][0][m][1] * inv, u0 = acc[ai][1][m][0] * (inv * SC_H), u1 = acc[ai][1][m][1] * (inv * SC_H);
                u32x2 w; w.x = pk4_fp8(silu_f(g0[0]) * u0[0], silu_f(g0[1]) * u0[1], silu_f(g0[2]) * u0[2], silu_f(g0[3]) * u0[3]);
                w.y = pk4_fp8(silu_f(g1[0]) * u1[0], silu_f(g1[1]) * u1[1], silu_f(g1[2]) * u1[2], silu_f(g1[3]) * u1[3]);
                *(u32x2*)((unsigned char*)O + (size_t)(row0 + ai * HALF + m * 16) * DE + col0) = w; }
    }
};
struct ProbDN {
    static constexpr bool PERM = true, GATHER = true, GATHER_A = true; static constexpr int ESZ = 1;
    const bf16_t* A; const bf16_t* Bt; const float* GATE; bf16_t* O;
    int nt, lda, ldb, G, c;
    __device__ __forceinline__ bool next(int i, Unit& u) const { const int L = i * G + c; if (L >= 1024) return false; const int wg = (L % 8) * 128 + L / 8; u.e = wg / 64; const int w = wg % 64; u.pm = w % 8; u.pn = w / 8; return true; }
    __device__ __forceinline__ const char* a_base(const Unit&) const { return (const char*)A; }
    __device__ __forceinline__ const char* b_base(const Unit& u) const { return (const char*)Bt + (size_t)(u.e * DM + u.pn * BM) * ldb; }
    __device__ __forceinline__ unsigned a_rowoff(const Unit& u, int, int r, LAS int*) const { return (unsigned)((u.e * ER + u.pm * BM + r) * lda); }
    __device__ __forceinline__ void fill_tab(LAS int* tab, int ui, const Unit& u, int tid) const { if (tid < 256 && ui < 8) ((LAS float*)tab)[ui * 256 + tid] = GATE[(u.e * 8 + u.pm) * 256 + tid]; }
    __device__ __forceinline__ void epi(const Acc& acc, const Unit& u, int ui, LAS int* tab, int wr, int wc, int fr, int fq) const {
        const int r0 = wr * 64 + fr, pos0 = u.pn * BM + wc * 64 + 16 * fq;
        const LAS float* gp = (const LAS float*)tab + ui * 256;
#pragma unroll
        for (int ai = 0; ai < 2; ++ai)
#pragma unroll
            for (int m = 0; m < 4; ++m) { const int r = r0 + ai * HALF + m * 16; const float gt = gp[r] * (Y_SCALE / (SC_H * SC_WDN));
                const f32x4 a0 = acc[ai][0][m][0] * gt, a1 = acc[ai][0][m][1] * gt, b0 = acc[ai][1][m][0] * gt, b1 = acc[ai][1][m][1] * gt;
                u32x4 w; w.x = pk4_fp8(a0[0], a0[1], a0[2], a0[3]); w.y = pk4_fp8(a1[0], a1[1], a1[2], a1[3]); w.z = pk4_fp8(b0[0], b0[1], b0[2], b0[3]); w.w = pk4_fp8(b1[0], b1[1], b1[2], b1[3]);
                *(u32x4*)((unsigned char*)O + (size_t)(u.e * ER + u.pm * BM + r) * DM + pos0) = w; }
    }
};
}

struct Ctx {
    LAS unsigned char* lds; int tid, lane, wave, G, gw, NGW;
    int rb, rs, re;
    unsigned char* ws; gu32* ctl;
};
#define WSP(T, off) ((T*)(C.ws + (off)))

struct TItem { const float* src; bf16_t* dst; int ldw, ldt; };
__device__ __forceinline__ TItem titem(const float* W, int ldw, int k0, int n0, bf16_t* WT, int ldt, int drow0, int lane) {
    const int kg = lane >> 3, ng = lane & 7;
    TItem t; t.src = W + (size_t)(k0 + 8 * kg) * ldw + n0 + 4 * ng; t.dst = WT + (size_t)(drow0 + n0 + 4 * ng) * ldt + k0 + 8 * kg; t.ldw = ldw; t.ldt = ldt; return t;
}
__device__ __forceinline__ void titem_load(const TItem& t, f32x4 (&v)[8]) {
#pragma unroll
    for (int r = 0; r < 8; ++r) v[r] = __builtin_nontemporal_load((const f32x4*)(t.src + (size_t)r * t.ldw));
}
__device__ __forceinline__ void titem_store(const TItem& t, const f32x4 (&v)[8]) {
#pragma unroll
    for (int q = 0; q < 4; ++q) { u32x4 o; o.x = pk2(v[0][q], v[1][q]); o.y = pk2(v[2][q], v[3][q]); o.z = pk2(v[4][q], v[5][q]); o.w = pk2(v[6][q], v[7][q]);
        __builtin_nontemporal_store(o, (u32x4*)(t.dst + (size_t)q * t.ldt)); }
}
__device__ __forceinline__ void transpose_item(const float* W, int ldw, int k0, int n0, bf16_t* WT, int ldt, int drow0, LAS float*, int lane) {
    const TItem t = titem(W, ldw, k0, n0, WT, ldt, drow0, lane); f32x4 v[8]; titem_load(t, v); titem_store(t, v);
}
__device__ __forceinline__ void rms_rows_bf16(const float* X, const float* g, bf16_t* O, float* RS, int first, int stride, int nrows, int lane) {
    if (first >= nrows) return;
    f32x4 gq[4][2], xn[4][2];
#pragma unroll
    for (int j = 0; j < 4; ++j)
#pragma unroll
        for (int q = 0; q < 2; ++q) { gq[j][q] = *(const f32x4*)(g + 8 * lane + 512 * j + 4 * q); xn[j][q] = __builtin_nontemporal_load((const f32x4*)(X + (size_t)first * DM + 8 * lane + 512 * j + 4 * q)); }
    for (int m = first; m < nrows; m += stride) {
        f32x4 v[4][2]; float ss = 0.f;
#pragma unroll
        for (int j = 0; j < 4; ++j)
#pragma unroll
            for (int q = 0; q < 2; ++q) { v[j][q] = xn[j][q]; ss += (v[j][q].x * v[j][q].x + v[j][q].y * v[j][q].y) + (v[j][q].z * v[j][q].z + v[j][q].w * v[j][q].w); }
        const int mn = (m + stride < nrows) ? m + stride : m;
#pragma unroll
        for (int j = 0; j < 4; ++j)
#pragma unroll
            for (int q = 0; q < 2; ++q) xn[j][q] = __builtin_nontemporal_load((const f32x4*)(X + (size_t)mn * DM + 8 * lane + 512 * j + 4 * q));
        const float r = 1.0f / sqrtf(wave_sum(ss) * (1.0f / DM) + EPS);
        if (RS != nullptr && lane == 0) RS[m] = 1.0f / r;
#pragma unroll
        for (int j = 0; j < 4; ++j) { const f32x4 a = v[j][0] * r * gq[j][0], b = v[j][1] * r * gq[j][1];
            u32x4 o; o.x = pk2(a.x, a.y); o.y = pk2(a.z, a.w); o.z = pk2(b.x, b.y); o.w = pk2(b.z, b.w);
            *(u32x4*)(O + (size_t)m * DM + 8 * lane + 512 * j) = o; }
    }
}
constexpr int IT_LE = 1024, IT_EXP = 2 * NE * IT_LE;
constexpr int CONV1_N = 256, CONV1_ITEMS = 64 * CONV1_N;
constexpr int CONV2_WG = 96, CONV2_N = 170, SLOT2_ITEMS = CONV2_WG * CONV2_N;
constexpr int DN10_N = 0, DN10_ITEMS = CONV2_WG * DN10_N;
static_assert(NE * 512 - DN10_ITEMS <= 4 * 2048, "P11 hides one down-weight item per wave in each of its 3 window-attention units and 1 cross-attention unit");
constexpr int IT_MOVED = CONV1_ITEMS + SLOT2_ITEMS, SLOT1_ITEMS = CONV1_ITEMS;
static_assert(SLOT2_ITEMS <= IT_EXP / 2 && IT_MOVED <= IT_EXP, "P10's items are layer-1 items (needed from P15 on); P1's may be of either layer (needed from P7 on)");
struct TItem8 { const float* src; unsigned char* dst; int ldw, ldt; float sc; };
__device__ __forceinline__ TItem8 expert_titem(int r, const float* w_gate, const float* w_up, const float*, unsigned char* ws, int lane) {
    const int le = r / IT_LE, rr = r % IT_LE, kind = rr >> 9, q = rr & 511, kg = lane >> 3, ng = lane & 7;
    const int kb = q >> 5, nb = q & 31, n0 = 32 * nb, k0 = 128 * kb;
    TItem8 t;
    t.src = (kind ? w_up : w_gate) + (size_t)le * DM * DE + (size_t)(k0 + 16 * kg) * DE + n0 + 4 * ng; t.ldw = DE;
    t.dst = ws + WS_WGU + (size_t)le * DM * DM + (size_t)((n0 >> 7) * 256 + kind * 128 + (n0 & 127) + 4 * ng) * DM + k0 + 16 * kg; t.ldt = DM; t.sc = pg8::SC_WGU;
    return t;
}
__device__ __forceinline__ void titem8_load(const TItem8& t, f32x4 (&v)[16]) {
#pragma unroll
    for (int r = 0; r < 16; ++r) v[r] = __builtin_nontemporal_load((const f32x4*)(t.src + (size_t)r * t.ldw));
}
__device__ __forceinline__ void titem8_load_seq(const TItem8& t, f32x4 (&v)[16]) {
    const float* p = t.src;
#pragma unroll
    for (int r = 0; r < 16; ++r) { v[r] = __builtin_nontemporal_load((const f32x4*)p); p += t.ldw; asm volatile("" : "+v"(p)); }
}
__device__ __forceinline__ void titem8_store(const TItem8& t, const f32x4 (&v)[16]) {
#pragma unroll
    for (int q = 0; q < 4; ++q) { u32x4 o;
        o.x = pk4_fp8(v[0][q] * t.sc, v[1][q] * t.sc, v[2][q] * t.sc, v[3][q] * t.sc); o.y = pk4_fp8(v[4][q] * t.sc, v[5][q] * t.sc, v[6][q] * t.sc, v[7][q] * t.sc);
        o.z = pk4_fp8(v[8][q] * t.sc, v[9][q] * t.sc, v[10][q] * t.sc, v[11][q] * t.sc); o.w = pk4_fp8(v[12][q] * t.sc, v[13][q] * t.sc, v[14][q] * t.sc, v[15][q] * t.sc);
        __builtin_nontemporal_store(o, (u32x4*)(t.dst + (size_t)q * t.ldt)); }
}
__device__ __forceinline__ void titem8_load_half(const TItem8& t, int half, f32x4 (&v)[8]) {
    const float* p = t.src + (size_t)(8 * half) * t.ldw;
#pragma unroll
    for (int r = 0; r < 8; ++r) { v[r] = __builtin_nontemporal_load((const f32x4*)p); p += t.ldw; asm volatile("" : "+v"(p)); }
}
__device__ __forceinline__ void titem8_store_half(const TItem8& t, int half, const f32x4 (&v)[8]) {
#pragma unroll
    for (int q = 0; q < 4; ++q) { u32x2 o;
        o.x = pk4_fp8(v[0][q] * t.sc, v[1][q] * t.sc, v[2][q] * t.sc, v[3][q] * t.sc); o.y = pk4_fp8(v[4][q] * t.sc, v[5][q] * t.sc, v[6][q] * t.sc, v[7][q] * t.sc);
        __builtin_nontemporal_store(o, (u32x2*)(t.dst + (size_t)q * t.ldt + 8 * half)); }
}
__device__ __forceinline__ void expert_items(int first, int stride, int end, const float* w_gate, const float* w_up, const float* w_down, unsigned char* ws, int lane) {
    int r = first;
    for (; r + stride < end; r += 2 * stride) {
        const TItem8 t0 = expert_titem(r, w_gate, w_up, w_down, ws, lane), t1 = expert_titem(r + stride, w_gate, w_up, w_down, ws, lane);
        f32x4 v0[16], v1[16]; titem8_load(t0, v0); titem8_load(t1, v1);
        titem8_store(t0, v0); titem8_store(t1, v1);
    }
    for (; r < end; r += stride) { const TItem8 t = expert_titem(r, w_gate, w_up, w_down, ws, lane); f32x4 v[16]; titem8_load(t, v); titem8_store(t, v); }
}
__device__ __forceinline__ TItem8 down_titem(int rr, const float* w_down, unsigned char* ws, int lane) {
    const int le = rr >> 9, q = rr & 511, kb = q >> 6, nb = q & 63, kg = lane >> 3, ng = lane & 7;
    TItem8 t; t.src = w_down + (size_t)le * DE * DM + (size_t)(128 * kb + 16 * kg) * DM + 32 * nb + 4 * ng; t.ldw = DM;
    t.dst = ws + WS_WDN + (size_t)le * DM * DE + (size_t)(32 * nb + 4 * ng) * DE + 128 * kb + 16 * kg; t.ldt = DE; t.sc = pg8::SC_WDN; return t;
}
__device__ __forceinline__ void down_items(int first, int stride, int end, const float* w_down, unsigned char* ws, int lane) {
    for (int r = first; r < end; r += 2 * stride) {
        TItem8 t[2];
#pragma unroll
        for (int i = 0; i < 2; ++i) { const int rr = (r + i * stride < end) ? r + i * stride : r, le = rr >> 9, q = rr & 511, kb = q >> 6, nb = q & 63, kg = lane >> 3, ng = lane & 7;
            t[i].src = w_down + (size_t)le * DE * DM + (size_t)(128 * kb + 16 * kg) * DM + 32 * nb + 4 * ng; t[i].ldw = DM;
            t[i].dst = ws + WS_WDN + (size_t)le * DM * DE + (size_t)(32 * nb + 4 * ng) * DE + 128 * kb + 16 * kg; t[i].ldt = DE; t[i].sc = pg8::SC_WDN; }
        f32x4 v0[16], v1[16]; titem8_load(t[0], v0); titem8_load(t[1], v1); titem8_store(t[0], v0); titem8_store(t[1], v1);
    }
}
__device__ __forceinline__ void expert_slot(const Ctx& C, int first, int n, const float* w_gate, const float* w_up, const float* w_down) {
    const int base = IT_EXP - IT_MOVED + first; expert_items(base + C.wave, NWAVES, base + n, w_gate, w_up, w_down, C.ws, C.lane);
}
__device__ __forceinline__ void w8_item(const float* W, int ldw, int k0, int n0, unsigned char* WT, int lane) {
    const int kg = lane >> 3, ng = lane & 7;
    TItem8 t; t.src = W + (size_t)(k0 + 16 * kg) * ldw + n0 + 4 * ng; t.ldw = ldw; t.dst = WT + (size_t)(n0 + 4 * ng) * DM + k0 + 16 * kg; t.ldt = DM; t.sc = 64.0f;
    f32x4 v[16]; titem8_load(t, v); titem8_store(t, v);
}
__device__ __forceinline__ void p0_prologue(const Ctx& C, const float* w_gate, const float* w_up, const float* w_down, const float* w_memkv, const float* w_pin, const float* w_pout, const float* w_aout, const float* w_ain, const float* w_grp,
                                            const float* x, const float* g_mix, const float* mem, const float* g_mem, const int* pos, const float* p_scale, const float* w_router) {
    LAS float* scr = (LAS float*)(C.lds + C.wave * 8448);
    constexpr int IT_NOW = IT_EXP - IT_MOVED;
    constexpr int IT_MKV = 2 * 1024, IT_PIN = 2048, IT_SQ = 2048, IT_AIN = 16 * 76, IT_AO8 = 1024, IT_GRP = 4 * 48;
    constexpr int NITEMS = IT_NOW + IT_MKV + IT_PIN + IT_SQ + IT_AO8 + IT_AIN + IT_GRP;
    expert_items(C.gw, C.NGW, IT_NOW, w_gate, w_up, w_down, C.ws, C.lane);
    for (int it = IT_NOW + C.gw; it < NITEMS; it += C.NGW) {
        int r = it - IT_NOW;
        if (r < IT_MKV) { const int l = r >> 10, q = r & 1023; transpose_item(w_memkv + (size_t)l * DM * 1024, 1024, 64 * (q >> 5), 32 * (q & 31), WSP(bf16_t, WS_WMEMKV) + (size_t)l * 1024 * DM, DM, 0, scr, C.lane); continue; }
        r -= IT_MKV;
        if (r < IT_PIN) { transpose_item(w_pin, DM, 64 * (r >> 6), 32 * (r & 63), WSP(bf16_t, WS_WPIN), DM, 0, scr, C.lane); continue; }
        r -= IT_PIN;
        if (r < IT_AIN) { w8_item(w_ain, AIN, 128 * (r / 76), 32 * (r % 76), WSP(unsigned char, WS_WAIN), C.lane); continue; }
        r -= IT_AIN;
        if (r < IT_SQ) { transpose_item(w_pout, DM, 64 * (r >> 6), 32 * (r & 63), WSP(bf16_t, WS_WPOUT), DM, 0, scr, C.lane);
            if (64 * (r >> 6) >= TOK) transpose_item(w_pout, DM, 64 * (r >> 6), 32 * (r & 63), WSP(bf16_t, WS_WPOUT2), DM, 0, scr, C.lane);
            continue; }
        r -= IT_SQ;
        if (r < IT_AO8) { w8_item(w_aout, DM, 128 * (r >> 6), 32 * (r & 63), WSP(unsigned char, WS_WAOUT), C.lane); continue; }
        r -= IT_AO8;
        {
            const int g = r / 48, c0 = (r % 48) * 8;
            for (int idx = C.lane; idx < 8 * 96; idx += 64) { const int cr = idx / 96, d4 = (idx % 96) * 4;
                const f32x4 w = *(const f32x4*)(w_grp + ((size_t)g * 384 + c0 + cr) * 384 + d4), sc = *(const f32x4*)(p_scale + g * 384 + d4);
                u32x2 o; o.x = pk2(w.x * sc.x, w.y * sc.y); o.y = pk2(w.z * sc.z, w.w * sc.w);
                *(u32x2*)(WSP(bf16_t, WS_WGRP) + ((size_t)g * 512 + c0 + cr) * 384 + d4) = o; } }
    }
    rms_rows_bf16(x, g_mix, WSP(bf16_t, WS_XN), WSP(float, WS_RINV), C.gw, C.NGW, M, C.lane);
    rms_rows_bf16(mem, g_mem, WSP(bf16_t, WS_MEMN), nullptr, C.gw, C.NGW, MR, C.lane);
    for (int idx = blockIdx.x * NTHR + C.tid; idx < 2 * NE * DM; idx += C.G * NTHR) {
        const int layer = idx / (NE * DM), e = (idx / DM) % NE, k = idx % DM;
        const float w = w_router[((size_t)layer * DM + k) * NE + e]; const bf16_t hi = f2bf(w); const bf16_t lo = f2bf(w - bf2f(hi));
        bf16_t* o = WSP(bf16_t, WS_WRT) + (size_t)layer * 2 * NE * DM + (size_t)e * DM + k; o[0] = hi; o[NE * DM] = lo;
    }
    for (int idx = blockIdx.x * NTHR + C.tid; idx < M * 8; idx += C.G * NTHR) {
        const int m = idx >> 3, i = idx & 7;
        const float invf = i == 0 ? 1.0f : i == 1 ? 0.1939227432012558f : i == 2 ? 0.03760603070259094f : i == 3 ? 0.007292664609849453f : i == 4 ? 0.0014142135623842478f : i == 5 ? 0.00027424818836152554f : i == 6 ? 5.3182957344688475e-05f : 1.0313385246263351e-05f;
        const float ang = (float)pos[m] * invf;
        const double a = (double)ang, k = __builtin_rint(a * 0.15915494309189535), rr = a - k * 6.283185307179586;
        const float rf = (float)rr;
        WSP(float, WS_ROPE)[idx] = cosf(rf); WSP(float, WS_ROPE + 512 * 1024)[idx] = sinf(rf);
    }
}

typedef short v4i16_t __attribute__((ext_vector_type(4)));
__device__ __forceinline__ s16x4 vtr(const LAS unsigned char* p) { return __builtin_bit_cast(s16x4, __builtin_amdgcn_ds_read_tr16_b64_v4i16((LAS v4i16_t*)p)); }
template <int DH, bool WIN, bool O8, int NIT>
__device__ __forceinline__ void attn_wave(const LAS unsigned char* KL, int kstr, const LAS unsigned char* VL, int vstr, const bf16x8 (&qf)[DH / 16],
                                          int koff, int kt_lo, int kt_hi, float m_run, float l_run, float cscale, bf16_t* obase, int ldo, LAS unsigned char* stg, int lane, int ditem, int dstep, const float* w_down, unsigned char* ws) {
    const int ql = lane & 31, h = lane >> 5;
    f32x16 o[DH / 32];
#pragma unroll
    for (int b = 0; b < DH / 32; ++b)
#pragma unroll
        for (int r = 0; r < 16; ++r) o[b][r] = 0.f;
    const LAS unsigned char* vbase = VL + (4 * h + ((lane & 15) >> 2)) * vstr + (16 * ((lane >> 4) & 1) + 4 * (lane & 3)) * 2;
    f32x4 dv[8];
    { int d0 = ditem; asm volatile("" : "+s"(d0)); const TItem8 dt = down_titem(d0, w_down, ws, lane); titem8_load_half(dt, 0, dv); }
    const int kt_q = (kt_hi - kt_lo) / (2 * NIT);
    for (int kt = kt_lo; kt < kt_hi; ++kt) {
#pragma unroll
        for (int hh = 1; hh < 2 * NIT; ++hh)
            if (kt == kt_lo + hh * kt_q) { int d1 = ditem + ((hh - 1) >> 1) * dstep, d2 = ditem + (hh >> 1) * dstep; asm volatile("" : "+s"(d1), "+s"(d2));
                const TItem8 dta = down_titem(d1, w_down, ws, lane), dtb = down_titem(d2, w_down, ws, lane); titem8_store_half(dta, (hh - 1) & 1, dv); titem8_load_half(dtb, hh & 1, dv); }
        f32x16 s;
#pragma unroll
        for (int r = 0; r < 16; ++r) s[r] = 0.f;
        const LAS unsigned char* kp = KL + ((kt + koff) * 32 + ql) * kstr + h * 16;
#pragma unroll
        for (int st = 0; st < DH / 16; ++st) { const bf16x8 kf = *(const LAS bf16x8*)(kp + st * 32); s = __builtin_amdgcn_mfma_f32_32x32x16_bf16(kf, qf[st], s, 0, 0, 0); }
        if (WIN) {
            if (kt == 0) {
#pragma unroll
                for (int r = 0; r < 16; ++r) if (crow(r, h) < ql) s[r] = -1e30f;
            }
            if (kt == 8) {
#pragma unroll
                for (int r = 0; r < 16; ++r) if (crow(r, h) > ql) s[r] = -1e30f;
            }
        }
        float mx = s[0];
#pragma unroll
        for (int r = 1; r < 16; ++r) mx = fmaxf(mx, s[r]);
        mx = fmaxf(mx, __shfl_xor(mx, 32));
        const float mxs = mx * cscale;
        if (__any(mxs > m_run + 8.0f)) {
            const float m_new = fmaxf(m_run, mxs), alpha = __builtin_amdgcn_exp2f(m_run - m_new);
            m_run = m_new; l_run *= alpha;
#pragma unroll
            for (int b = 0; b < DH / 32; ++b)
#pragma unroll
                for (int r = 0; r < 16; ++r) o[b][r] *= alpha;
        }
        const float nm = -m_run; float ps = 0.f;
#pragma unroll
        for (int r = 0; r < 16; ++r) { s[r] = __builtin_amdgcn_exp2f(__builtin_fmaf(s[r], cscale, nm)); ps += s[r]; }
        l_run += ps;
        bf16x8 pf[2];
#pragma unroll
        for (int s2 = 0; s2 < 2; ++s2) { u32x4 w; w.x = pk2(s[8 * s2 + 0], s[8 * s2 + 1]); w.y = pk2(s[8 * s2 + 2], s[8 * s2 + 3]); w.z = pk2(s[8 * s2 + 4], s[8 * s2 + 5]); w.w = pk2(s[8 * s2 + 6], s[8 * s2 + 7]); pf[s2] = __builtin_bit_cast(bf16x8, w); }
        const LAS unsigned char* vp = vbase + ((kt + koff) * 32) * vstr;
#pragma unroll
        for (int b = 0; b < DH / 32; ++b) {
#pragma unroll
            for (int s2 = 0; s2 < 2; ++s2) {
                const s16x4 lo = vtr(vp + (16 * s2) * vstr + b * 64), hi = vtr(vp + (16 * s2 + 8) * vstr + b * 64);
                const bf16x8 vf = (bf16x8){lo[0], lo[1], lo[2], lo[3], hi[0], hi[1], hi[2], hi[3]};
                o[b] = __builtin_amdgcn_mfma_f32_32x32x16_bf16(vf, pf[s2], o[b], 0, 0, 0);
            }
        }
    }
    { int d2 = ditem + (NIT - 1) * dstep; asm volatile("" : "+s"(d2)); const TItem8 dt = down_titem(d2, w_down, ws, lane); titem8_store_half(dt, 1, dv); }
    const float lt = l_run + __shfl_xor(l_run, 32), rl = 1.0f / lt;
    __syncthreads();
    if constexpr (O8) {
        constexpr int SST = DH + 16; const float rs = rl * SC_CAT;
#pragma unroll
        for (int b = 0; b < DH / 32; ++b)
#pragma unroll
            for (int rg = 0; rg < 4; ++rg) *(LAS unsigned*)(stg + ql * SST + (b * 32 + 8 * rg + 4 * h)) = pk4_fp8(o[b][4 * rg] * rs, o[b][4 * rg + 1] * rs, o[b][4 * rg + 2] * rs, o[b][4 * rg + 3] * rs);
        constexpr int CPR = DH / 16, RPI = 64 / CPR;
#pragma unroll
        for (int i = 0; i < 32 / RPI; ++i) { const int row = i * RPI + lane / CPR, ch = lane % CPR;
            const u32x4 v = *(const LAS u32x4*)(stg + row * SST + ch * 16);
            *(u32x4*)((unsigned char*)obase + (size_t)row * ldo + ch * 16) = v; }
    } else {
    constexpr int SST = DH * 2 + 16;
#pragma unroll
    for (int b = 0; b < DH / 32; ++b)
#pragma unroll
        for (int rg = 0; rg < 4; ++rg) { u32x2 w; w.x = pk2(o[b][4 * rg] * rl, o[b][4 * rg + 1] * rl); w.y = pk2(o[b][4 * rg + 2] * rl, o[b][4 * rg + 3] * rl);
            *(LAS u32x2*)(stg + ql * SST + (b * 32 + 8 * rg + 4 * h) * 2) = w; }
    constexpr int CPR = DH / 8, RPI = 64 / CPR;
#pragma unroll
    for (int i = 0; i < 32 / RPI; ++i) { const int row = i * RPI + lane / CPR, ch = lane % CPR;
        const u32x4 v = *(const LAS u32x4*)(stg + row * SST + ch * 16);
        *(u32x4*)(obase + (size_t)row * ldo + ch * 8) = v; }
    }
}

__device__ __forceinline__ void attn_win2(const LAS unsigned char* KL, int kstr, const LAS unsigned char* VL, int vstr, const bf16x8 (&qfA)[4], const bf16x8 (&qfB)[4],
                                          int j_lo, int j_hi, float m0, float cscale, unsigned char* obaseA, unsigned char* obaseB, int ldo, LAS unsigned char* stg, int lane, int ditem, const float* w_down, unsigned char* ws) {
    const int ql = lane & 31, h = lane >> 5;
    f32x16 oA[2], oB[2];
#pragma unroll
    for (int b = 0; b < 2; ++b)
#pragma unroll
        for (int r = 0; r < 16; ++r) { oA[b][r] = 0.f; oB[b][r] = 0.f; }
    float mA = m0, mB = m0, lA = h ? 0.f : 1.f, lB = h ? 0.f : 1.f;
    const LAS unsigned char* vbase = VL + (4 * h + ((lane & 15) >> 2)) * vstr + (16 * ((lane >> 4) & 1) + 4 * (lane & 3)) * 2;
#define WA_QK(S, QF) do { _Pragma("unroll") for (int r = 0; r < 16; ++r) S[r] = 0.f; \
        _Pragma("unroll") for (int st = 0; st < 4; ++st) { const bf16x8 kf_ = *(const LAS bf16x8*)(kp + st * 32); S = __builtin_amdgcn_mfma_f32_32x32x16_bf16(kf_, QF[st], S, 0, 0, 0); } } while (0)
#define WA_QK2(SA, SB) do { _Pragma("unroll") for (int r = 0; r < 16; ++r) { SA[r] = 0.f; SB[r] = 0.f; } \
        _Pragma("unroll") for (int st = 0; st < 4; ++st) { const bf16x8 kf_ = *(const LAS bf16x8*)(kp + st * 32); SA = __builtin_amdgcn_mfma_f32_32x32x16_bf16(kf_, qfA[st], SA, 0, 0, 0); SB = __builtin_amdgcn_mfma_f32_32x32x16_bf16(kf_, qfB[st], SB, 0, 0, 0); } } while (0)
#define WA_MASK_LO(S) do { _Pragma("unroll") for (int r = 0; r < 16; ++r) if (crow(r, h) < ql) S[r] = -1e30f; } while (0)
#define WA_MASK_HI(S) do { _Pragma("unroll") for (int r = 0; r < 16; ++r) if (crow(r, h) > ql) S[r] = -1e30f; } while (0)
#define WA_SMPV(S, O, MR, LR) do { float mx_ = S[0]; _Pragma("unroll") for (int r = 1; r < 16; ++r) mx_ = fmaxf(mx_, S[r]); \
        mx_ = fmaxf(mx_, __shfl_xor(mx_, 32)); const float mxs_ = mx_ * cscale; \
        if (__any(mxs_ > MR + 8.0f)) { const float mn_ = fmaxf(MR, mxs_), al_ = __builtin_amdgcn_exp2f(MR - mn_); MR = mn_; LR *= al_; \
            _Pragma("unroll") for (int b = 0; b < 2; ++b) _Pragma("unroll") for (int r = 0; r < 16; ++r) O[b][r] *= al_; } \
        const float nm_ = -MR; float ps_ = 0.f; \
        _Pragma("unroll") for (int r = 0; r < 16; ++r) { S[r] = __builtin_amdgcn_exp2f(__builtin_fmaf(S[r], cscale, nm_)); ps_ += S[r]; } \
        LR += ps_; \
        _Pragma("unroll") for (int s2 = 0; s2 < 2; ++s2) { u32x4 w_; w_.x = pk2(S[8 * s2 + 0], S[8 * s2 + 1]); w_.y = pk2(S[8 * s2 + 2], S[8 * s2 + 3]); w_.z = pk2(S[8 * s2 + 4], S[8 * s2 + 5]); w_.w = pk2(S[8 * s2 + 6], S[8 * s2 + 7]); \
            const bf16x8 pf_ = __builtin_bit_cast(bf16x8, w_); \
            _Pragma("unroll") for (int b = 0; b < 2; ++b) { const s16x4 lo_ = vtr(vp + (16 * s2) * vstr + b * 64), hi_ = vtr(vp + (16 * s2 + 8) * vstr + b * 64); \
                const bf16x8 vf_ = (bf16x8){lo_[0], lo_[1], lo_[2], lo_[3], hi_[0], hi_[1], hi_[2], hi_[3]}; O[b] = __builtin_amdgcn_mfma_f32_32x32x16_bf16(vf_, pf_, O[b], 0, 0, 0); } } } while (0)
    f32x4 dv[8];
    { int d0 = ditem; asm volatile("" : "+s"(d0)); const TItem8 dt = down_titem(d0, w_down, ws, lane); titem8_load_half(dt, 0, dv); }
    for (int j = j_lo; j < j_hi; ++j) {
        if (j == 5) { int d1 = ditem; asm volatile("" : "+s"(d1)); const TItem8 dt = down_titem(d1, w_down, ws, lane); titem8_store_half(dt, 0, dv); titem8_load_half(dt, 1, dv); }
        const LAS unsigned char* kp = KL + (j * 32 + ql) * kstr + h * 16;
        const LAS unsigned char* vp = vbase + (j * 32) * vstr;
        f32x16 sA, sB;
        if (j >= 2 && j <= 7) {
            WA_QK2(sA, sB);
            WA_SMPV(sA, oA, mA, lA); WA_SMPV(sB, oB, mB, lB);
        } else {
            if (j <= 8) { WA_QK(sA, qfA); if (j == 0) WA_MASK_LO(sA); if (j == 8) WA_MASK_HI(sA); WA_SMPV(sA, oA, mA, lA); }
            if (j >= 1) { WA_QK(sB, qfB); if (j == 1) WA_MASK_LO(sB); if (j == 9) WA_MASK_HI(sB); WA_SMPV(sB, oB, mB, lB); }
        }
    }
    { int d2 = ditem; asm volatile("" : "+s"(d2)); const TItem8 dt = down_titem(d2, w_down, ws, lane); titem8_store_half(dt, 1, dv); }
#undef WA_QK
#undef WA_QK2
#undef WA_MASK_LO
#undef WA_MASK_HI
#undef WA_SMPV
    const float rlA = 1.0f / (lA + __shfl_xor(lA, 32)), rlB = 1.0f / (lB + __shfl_xor(lB, 32));
    const float rsA = rlA * SC_CAT, rsB = rlB * SC_CAT;
#pragma unroll
    for (int t2 = 0; t2 < 2; ++t2) {
#pragma unroll
        for (int b = 0; b < 2; ++b)
#pragma unroll
            for (int rg = 0; rg < 4; ++rg) { unsigned w;
                if (t2 == 0) w = pk4_fp8(oA[b][4 * rg] * rsA, oA[b][4 * rg + 1] * rsA, oA[b][4 * rg + 2] * rsA, oA[b][4 * rg + 3] * rsA);
                else         w = pk4_fp8(oB[b][4 * rg] * rsB, oB[b][4 * rg + 1] * rsB, oB[b][4 * rg + 2] * rsB, oB[b][4 * rg + 3] * rsB);
                *(LAS unsigned*)(stg + ql * 80 + (b * 32 + 8 * rg + 4 * h)) = w; }
        unsigned char* ob = t2 ? obaseB : obaseA;
#pragma unroll
        for (int i = 0; i < 2; ++i) { const int row = i * 16 + (lane >> 2), ch = lane & 3;
            const u32x4 v = *(const LAS u32x4*)(stg + row * 80 + ch * 16);
            *(u32x4*)(ob + (size_t)row * ldo + ch * 16) = v; }
    }
}

template <bool O8, int NIT>
__device__ __forceinline__ void xattn_unit(const Ctx& C, int u, const bf16_t* PROJ, int ldp, int qcol0, int kvcol0, int ditem, int dstep, const float* w_down) {
    constexpr int KSTR = 272, VSTR = 288;
    LAS unsigned char* KL = C.lds; LAS unsigned char* VL = C.lds + 256 * KSTR;
    const int b = u >> 5, head = (u >> 3) & 3, qt = u & 7;
    const bf16_t* KV = WSP(bf16_t, WS_MEMKV) + (size_t)(b * MEML) * DM + kvcol0 + head * 128;
    const int row = b * SEQ + qt * 256 + C.wave * 32 + (C.lane & 31), h = C.lane >> 5;
    bf16x8 qf[8];
#pragma unroll
    for (int st = 0; st < 8; ++st) qf[st] = *(const bf16x8*)(PROJ + (size_t)row * ldp + qcol0 + head * 128 + st * 16 + h * 8);
    __syncthreads();
    {
        u32x4 kv[8], vv[8];
#pragma unroll
        for (int k = 0; k < 8; ++k) { const int it = C.tid + k * NTHR, i = it >> 4, c = it & 15;
            kv[k] = *(const u32x4*)(KV + (size_t)i * DM + c * 8); vv[k] = *(const u32x4*)(KV + (size_t)i * DM + 512 + c * 8); }
#pragma unroll
        for (int k = 0; k < 8; ++k) { const int it = C.tid + k * NTHR, i = it >> 4, c = it & 15;
            *(LAS u32x4*)(KL + i * KSTR + c * 16) = kv[k]; *(LAS u32x4*)(VL + i * VSTR + c * 16) = vv[k]; }
    }
    LDS_WAIT(); __syncthreads();
    bf16_t* ob = O8 ? (bf16_t*)(WSP(unsigned char, WS_CAT) + (size_t)(b * SEQ + qt * 256 + C.wave * 32) * DM + TOK + head * 128) : WSP(bf16_t, WS_CAT) + (size_t)(b * SEQ + qt * 256 + C.wave * 32) * DM + TOK + head * 128;
    attn_wave<128, false, O8, NIT>(KL, KSTR, VL, VSTR, qf, 0, 0, 8, -1e30f, 0.f, 0.08838834764831845f * LOG2E, ob, DM, KL + C.wave * (32 * 272), C.lane, ditem, dstep, w_down, C.ws);
}
__device__ __forceinline__ void wattn_unit(const Ctx& C0, int u, const float* sinkp, int ditem, const float* w_down) {
    Ctx C = C0; asm volatile("" : "+v"(C.tid), "+v"(C.lane));
    constexpr int KSTR = 144, VSTR = 192, NK = 320;
    LAS unsigned char* KL = C.lds; LAS unsigned char* VL = C.lds + NK * KSTR;
    const int b = u / 96, kvh = (u / 32) % 3, qt = u % 32, q0u = qt * 64, kbase = q0u - 128;
    const bf16_t* P = WSP(bf16_t, WS_PROJ);
    const float* RC = WSP(float, WS_ROPE); const float* RS = WSP(float, WS_ROPE + 512 * 1024);
    const int head = kvh * 8 + C.wave, h = C.lane >> 5;
    const float sk = sinkp[head] * LOG2E;
    bf16x8 qf[2][4]; f32x4 qc0[2], qc1[2], qs0[2], qs1[2];
#pragma unroll
    for (int t2 = 0; t2 < 2; ++t2) {
        const size_t row = (size_t)(b * SEQ + q0u + t2 * 32 + (C.lane & 31));
#pragma unroll
        for (int st = 0; st < 4; ++st) qf[t2][st] = *(const bf16x8*)(P + row * AINP + head * 64 + st * 16 + h * 8);
        qc0[t2] = *(const f32x4*)(RC + row * 8); qc1[t2] = *(const f32x4*)(RC + row * 8 + 4); qs0[t2] = *(const f32x4*)(RS + row * 8); qs1[t2] = *(const f32x4*)(RS + row * 8 + 4);
    }

    __syncthreads();
    {
        u32x4 kv[4], vv[5];
#pragma unroll
        for (int k = 0; k < 4; ++k) { const int it = C.tid + k * NTHR, i = it / 6, c = 2 + it % 6, kpos = kbase + i;
            kv[k] = (it < NK * 6 && kpos >= 0 && kpos < SEQ) ? *(const u32x4*)(P + (size_t)(b * SEQ + kpos) * AINP + TOK + kvh * 64 + c * 8) : (u32x4){0u, 0u, 0u, 0u}; }
#pragma unroll
        for (int k = 0; k < 5; ++k) { const int it = C.tid + k * NTHR, i = it >> 3, c = it & 7, kpos = kbase + i;
            vv[k] = (kpos >= 0 && kpos < SEQ) ? *(const u32x4*)(P + (size_t)(b * SEQ + kpos) * AINP + TOK + KVW + kvh * 64 + c * 8) : (u32x4){0u, 0u, 0u, 0u}; }
        if (C.tid < NK) {
            const int i = C.tid, kpos = kbase + i;
            if (kpos >= 0 && kpos < SEQ) {
                const size_t rowi = (size_t)(b * SEQ + kpos);
                const bf16_t* kr = P + rowi * AINP + TOK + kvh * 64;
                const u32x4 k1 = *(const u32x4*)kr, k2 = *(const u32x4*)(kr + 8);
                const f32x4 c0 = *(const f32x4*)(RC + rowi * 8), c1 = *(const f32x4*)(RC + rowi * 8 + 4), s0 = *(const f32x4*)(RS + rowi * 8), s1 = *(const f32x4*)(RS + rowi * 8 + 4);
                u32x4 n1, n2;
                n1.x = pk2(lo16(k1.x) * c0.x - lo16(k2.x) * s0.x, hi16(k1.x) * c0.y - hi16(k2.x) * s0.y); n2.x = pk2(lo16(k2.x) * c0.x + lo16(k1.x) * s0.x, hi16(k2.x) * c0.y + hi16(k1.x) * s0.y);
                n1.y = pk2(lo16(k1.y) * c0.z - lo16(k2.y) * s0.z, hi16(k1.y) * c0.w - hi16(k2.y) * s0.w); n2.y = pk2(lo16(k2.y) * c0.z + lo16(k1.y) * s0.z, hi16(k2.y) * c0.w + hi16(k1.y) * s0.w);
                n1.z = pk2(lo16(k1.z) * c1.x - lo16(k2.z) * s1.x, hi16(k1.z) * c1.y - hi16(k2.z) * s1.y); n2.z = pk2(lo16(k2.z) * c1.x + lo16(k1.z) * s1.x, hi16(k2.z) * c1.y + hi16(k1.z) * s1.y);
                n1.w = pk2(lo16(k1.w) * c1.z - lo16(k2.w) * s1.z, hi16(k1.w) * c1.w - hi16(k2.w) * s1.w); n2.w = pk2(lo16(k2.w) * c1.z + lo16(k1.w) * s1.z, hi16(k2.w) * c1.w + hi16(k1.w) * s1.w);
                *(LAS u32x4*)(KL + i * KSTR) = n1; *(LAS u32x4*)(KL + i * KSTR + 16) = n2;
            }
        }
#pragma unroll
        for (int k = 0; k < 4; ++k) { const int it = C.tid + k * NTHR, i = it / 6, c = 2 + it % 6; if (it < NK * 6) *(LAS u32x4*)(KL + i * KSTR + c * 16) = kv[k]; }
#pragma unroll
        for (int k = 0; k < 5; ++k) { const int it = C.tid + k * NTHR, i = it >> 3, c = it & 7; *(LAS u32x4*)(VL + i * VSTR + c * 16) = vv[k]; }
    }
#pragma unroll
    for (int t2 = 0; t2 < 2; ++t2) {
        const u32x4 mine = __builtin_bit_cast(u32x4, qf[t2][0]);
        u32x4 oth; oth.x = __shfl_xor(mine.x, 32); oth.y = __shfl_xor(mine.y, 32); oth.z = __shfl_xor(mine.z, 32); oth.w = __shfl_xor(mine.w, 32);
        const f32x4 c0 = qc0[t2], c1 = qc1[t2], s0 = qs0[t2], s1 = qs1[t2];
        const float sg = h ? 1.f : -1.f;
        u32x4 nv;
        nv.x = pk2(lo16(mine.x) * c0.x + sg * lo16(oth.x) * s0.x, hi16(mine.x) * c0.y + sg * hi16(oth.x) * s0.y);
        nv.y = pk2(lo16(mine.y) * c0.z + sg * lo16(oth.y) * s0.z, hi16(mine.y) * c0.w + sg * hi16(oth.y) * s0.w);
        nv.z = pk2(lo16(mine.z) * c1.x + sg * lo16(oth.z) * s1.x, hi16(mine.z) * c1.y + sg * hi16(oth.z) * s1.y);
        nv.w = pk2(lo16(mine.w) * c1.z + sg * lo16(oth.w) * s1.z, hi16(mine.w) * c1.w + sg * hi16(oth.w) * s1.w);
        qf[t2][0] = __builtin_bit_cast(bf16x8, nv);
    }
    LDS_WAIT(); __syncthreads();
    {
        const size_t rowA = (size_t)(b * SEQ + q0u + (C.lane & 31));
        const int j_lo = q0u >= 128 ? 0 : (128 - q0u) / 32;
        int j_hi = (SEQ + 128 - q0u) / 32; if (j_hi > 10) j_hi = 10;
        const size_t row0 = (size_t)(b * SEQ + q0u);
        attn_win2(KL, KSTR, VL, VSTR, qf[0], qf[1], j_lo, j_hi, sk, 0.125f * LOG2E, WSP(unsigned char, WS_CAT) + row0 * DM + head * 64, WSP(unsigned char, WS_CAT) + (row0 + 32) * DM + head * 64, DM, VL + NK * VSTR + C.wave * (32 * 144), C.lane, ditem, w_down, C.ws);
    }
}

template <int HW>
__device__ __forceinline__ void pool_item4(const bf16_t* P, bf16_t* O, int m0, int c) {
    const int t0 = m0 & (SEQ - 1);
    const bf16_t* base = P + (size_t)(m0 - t0) * DM + c * 8;
    constexpr int NR = 2 * HW + 3;
    u32x4 v[NR];
#pragma unroll
    for (int jj = 0; jj < NR; ++jj) { int j = t0 - HW + jj; j = j < 0 ? 0 : (j > SEQ - 1 ? SEQ - 1 : j); v[jj] = *(const u32x4*)(base + (size_t)j * DM); }
    float a[8];
#pragma unroll
    for (int k = 0; k < 8; ++k) a[k] = 0.f;
#pragma unroll
    for (int jj = 0; jj < 2 * HW; ++jj) { const int j = t0 - HW + jj; const float wv = (j >= 0 && j < SEQ) ? 1.f : 0.f;
        a[0] += wv * lo16(v[jj].x); a[1] += wv * hi16(v[jj].x); a[2] += wv * lo16(v[jj].y); a[3] += wv * hi16(v[jj].y);
        a[4] += wv * lo16(v[jj].z); a[5] += wv * hi16(v[jj].z); a[6] += wv * lo16(v[jj].w); a[7] += wv * hi16(v[jj].w); }
#pragma unroll
    for (int i = 0; i < 4; ++i) {
        const int t = t0 + i;
        if (i > 0) {
            const int jo = t - 1 - HW, jn = t + HW - 1; const float wo = (jo >= 0) ? 1.f : 0.f, wn = (jn < SEQ) ? 1.f : 0.f;
            const u32x4 vo = v[i - 1], vn = v[2 * HW + i - 1];
            a[0] += wn * lo16(vn.x) - wo * lo16(vo.x); a[1] += wn * hi16(vn.x) - wo * hi16(vo.x); a[2] += wn * lo16(vn.y) - wo * lo16(vo.y); a[3] += wn * hi16(vn.y) - wo * hi16(vo.y);
            a[4] += wn * lo16(vn.z) - wo * lo16(vo.z); a[5] += wn * hi16(vn.z) - wo * hi16(vo.z); a[6] += wn * lo16(vn.w) - wo * lo16(vo.w); a[7] += wn * hi16(vn.w) - wo * hi16(vo.w);
        }
        int lo = t - HW; if (lo < 0) lo = 0; int hi = t + HW - 1; if (hi > SEQ - 1) hi = SEQ - 1;
        const float rc = 1.0f / (float)(hi - lo + 1);
        const u32x4 sv = v[HW + i];
        u32x4 o; o.x = pk2(a[0] * rc - lo16(sv.x), a[1] * rc - hi16(sv.x)); o.y = pk2(a[2] * rc - lo16(sv.y), a[3] * rc - hi16(sv.y));
        o.z = pk2(a[4] * rc - lo16(sv.z), a[5] * rc - hi16(sv.z)); o.w = pk2(a[6] * rc - lo16(sv.w), a[7] * rc - hi16(sv.w));
        *(u32x4*)(O + (size_t)(m0 + i) * DM + c * 8) = o;
    }
}
__device__ __forceinline__ void pool_phase(const Ctx& C) {
    const bf16_t* P = WSP(bf16_t, WS_PROJ); bf16_t* O = WSP(bf16_t, WS_CAT);
    if (C.lane >= 48) return;
    for (int wi = C.rb; wi < C.re; wi += C.rs) {
        const int g = wi & 3, m0 = 4 * (wi >> 2), c = g * 48 + C.lane;
        if (g == 0) pool_item4<1>(P, O, m0, c); else if (g == 1) pool_item4<2>(P, O, m0, c); else if (g == 2) pool_item4<4>(P, O, m0, c); else pool_item4<8>(P, O, m0, c);
    }
}

__device__ __forceinline__ void router_phase(const Ctx& C, const bf16_t* X, const float* g, const float* Wr) {
    LAS float* WL = (LAS float*)C.lds;
    __syncthreads();
    for (int idx = C.tid; idx < DM * NE / 4; idx += NTHR) { const f32x4 w = *(const f32x4*)(Wr + (size_t)idx * 4); const int k = idx >> 2, e0 = (idx & 3) * 4;
        WL[(e0 + 0) * DM + k] = w.x; WL[(e0 + 1) * DM + k] = w.y; WL[(e0 + 2) * DM + k] = w.z; WL[(e0 + 3) * DM + k] = w.w; }
    LDS_WAIT(); __syncthreads();
    unsigned char* XN8 = WSP(unsigned char, WS_XN8); float* AFFT = WSP(float, WS_AFFT);
    u32x2 xa[8], xb[8]; f32x4 gq[8];
#pragma unroll
    for (int jj = 0; jj < 8; ++jj) gq[jj] = *(const f32x4*)(g + 4 * C.lane + 256 * jj);
    if (C.gw < M) {
        const int mb = (C.gw + C.NGW < M) ? C.gw + C.NGW : C.gw;
#pragma unroll
        for (int jj = 0; jj < 8; ++jj) { xa[jj] = *(const u32x2*)(X + (size_t)C.gw * DM + 4 * C.lane + 256 * jj); xb[jj] = *(const u32x2*)(X + (size_t)mb * DM + 4 * C.lane + 256 * jj); }
    }
    for (int m0 = C.gw; m0 < M; m0 += 2 * C.NGW) {
        const bool two = m0 + C.NGW < M; const int m1 = two ? m0 + C.NGW : m0;
        u32x2 ca[8], cb[8]; float ssa = 0.f, ssb = 0.f;
#pragma unroll
        for (int jj = 0; jj < 8; ++jj) { ca[jj] = xa[jj]; cb[jj] = xb[jj];
            const float a0 = lo16(ca[jj].x), a1 = hi16(ca[jj].x), a2 = lo16(ca[jj].y), a3 = hi16(ca[jj].y), b0 = lo16(cb[jj].x), b1 = hi16(cb[jj].x), b2_ = lo16(cb[jj].y), b3_ = hi16(cb[jj].y);
            ssa += (a0 * a0 + a1 * a1) + (a2 * a2 + a3 * a3); ssb += (b0 * b0 + b1 * b1) + (b2_ * b2_ + b3_ * b3_); }
        { const int na = (m0 + 2 * C.NGW < M) ? m0 + 2 * C.NGW : m0, nb = (m0 + 3 * C.NGW < M) ? m0 + 3 * C.NGW : na;
#pragma unroll
          for (int jj = 0; jj < 8; ++jj) { xa[jj] = *(const u32x2*)(X + (size_t)na * DM + 4 * C.lane + 256 * jj); xb[jj] = *(const u32x2*)(X + (size_t)nb * DM + 4 * C.lane + 256 * jj); } }
        const float ra = 1.0f / sqrtf(wave_sum(ssa) * (1.0f / DM) + EPS), rb = 1.0f / sqrtf(wave_sum(ssb) * (1.0f / DM) + EPS);
        f32x2 lab[NE];
#pragma unroll
        for (int e = 0; e < NE; ++e) lab[e] = (f32x2){0.f, 0.f};
#pragma unroll
        for (int jj = 0; jj < 8; ++jj) {
            const f32x4 a = (f32x4){lo16(ca[jj].x), hi16(ca[jj].x), lo16(ca[jj].y), hi16(ca[jj].y)} * ra * gq[jj], b = (f32x4){lo16(cb[jj].x), hi16(cb[jj].x), lo16(cb[jj].y), hi16(cb[jj].y)} * rb * gq[jj];
            *(unsigned*)(XN8 + (size_t)m0 * DM + 4 * C.lane + 256 * jj) = pk4_fp8(a.x * pg8::SC_X, a.y * pg8::SC_X, a.z * pg8::SC_X, a.w * pg8::SC_X);
            *(unsigned*)(XN8 + (size_t)m1 * DM + 4 * C.lane + 256 * jj) = pk4_fp8(b.x * pg8::SC_X, b.y * pg8::SC_X, b.z * pg8::SC_X, b.w * pg8::SC_X);
            const f32x2 p0 = {a.x, b.x}, p1 = {a.y, b.y}, p2 = {a.z, b.z}, p3 = {a.w, b.w};
#pragma unroll
            for (int e = 0; e < NE; ++e) { const f32x4 w = *(const LAS f32x4*)(WL + e * DM + 256 * jj + 4 * C.lane);
                lab[e] = __builtin_elementwise_fma(p0, (f32x2){w.x, w.x}, lab[e]); lab[e] = __builtin_elementwise_fma(p1, (f32x2){w.y, w.y}, lab[e]);
                lab[e] = __builtin_elementwise_fma(p2, (f32x2){w.z, w.z}, lab[e]); lab[e] = __builtin_elementwise_fma(p3, (f32x2){w.w, w.w}, lab[e]);
                if ((e & 7) == 7) asm volatile("" : "+v"(lab[e]) :: "memory"); }
        }
        const bool b5 = C.lane & 32, b4 = C.lane & 16, b3 = C.lane & 8, b2 = C.lane & 4;
        const int eidx = ((C.lane >> 5) & 1) * 8 + ((C.lane >> 4) & 1) * 4 + ((C.lane >> 3) & 1) * 2 + ((C.lane >> 2) & 1);
#pragma unroll
        for (int rr = 0; rr < 2; ++rr) {
            float v8[8], v4[4], v2[2];
#pragma unroll
            for (int i = 0; i < 8; ++i) { const float lo = rr ? lab[i].y : lab[i].x, hi = rr ? lab[8 + i].y : lab[8 + i].x; v8[i] = (b5 ? hi : lo) + __shfl_xor(b5 ? lo : hi, 32); }
#pragma unroll
            for (int i = 0; i < 4; ++i) v4[i] = (b4 ? v8[4 + i] : v8[i]) + __shfl_xor(b4 ? v8[i] : v8[4 + i], 16);
#pragma unroll
            for (int i = 0; i < 2; ++i) v2[i] = (b3 ? v4[2 + i] : v4[i]) + __shfl_xor(b3 ? v4[i] : v4[2 + i], 8);
            float lgt = (b2 ? v2[1] : v2[0]) + __shfl_xor(b2 ? v2[0] : v2[1], 4);
            lgt += __shfl_xor(lgt, 2); lgt += __shfl_xor(lgt, 1);
            float mx = lgt;
            mx = fmaxf(mx, __shfl_xor(mx, 32)); mx = fmaxf(mx, __shfl_xor(mx, 16)); mx = fmaxf(mx, __shfl_xor(mx, 8)); mx = fmaxf(mx, __shfl_xor(mx, 4));
            const float ex = __expf(lgt - mx);
            float se = ex;
            se += __shfl_xor(se, 32); se += __shfl_xor(se, 16); se += __shfl_xor(se, 8); se += __shfl_xor(se, 4);
            const int m = rr ? m1 : m0;
            if ((C.lane & 3) == 0 && (rr == 0 || two)) AFFT[((size_t)(m >> 11) * NE + eidx) * SEQ + (m & (SEQ - 1))] = ex / se;
        }
    }
}

__device__ __forceinline__ void router_phase_mfma(const Ctx& C, const bf16_t* X, const float* g, const bf16_t* WRT) {
    constexpr int RS = 4112;
    LAS unsigned char* T = C.lds; LAS float* PART = (LAS float*)(C.lds + 32 * RS);
    unsigned char* XN8 = WSP(unsigned char, WS_XN8); float* AFFT = WSP(float, WS_AFFT);
    const int l15 = C.lane & 15, kq = C.lane >> 4;
    bf16x8 bhi[8], blo[8];
#pragma unroll
    for (int s2 = 0; s2 < 8; ++s2) { const bf16_t* wp = WRT + (size_t)l15 * DM + 256 * C.wave + 32 * s2 + 8 * kq; bhi[s2] = *(const bf16x8*)wp; blo[s2] = *(const bf16x8*)(wp + NE * DM); }
    f32x4 gq[8];
#pragma unroll
    for (int jj = 0; jj < 8; ++jj) gq[jj] = *(const f32x4*)(g + 4 * C.lane + 256 * jj);
    u32x2 xr[4][8];
#pragma unroll
    for (int i = 0; i < 4; ++i)
#pragma unroll
        for (int jj = 0; jj < 8; ++jj) xr[i][jj] = *(const u32x2*)(X + (size_t)(C.rb + i * C.rs) * DM + 4 * C.lane + 256 * jj);
#pragma unroll
    for (int p = 0; p < 2; ++p) {
        __syncthreads();
#pragma unroll
        for (int i = 0; i < 4; ++i) {
            const int m = C.rb + (4 * p + i) * C.rs;
            float ss = 0.f;
#pragma unroll
            for (int jj = 0; jj < 8; ++jj) { const float a0 = lo16(xr[i][jj].x), a1 = hi16(xr[i][jj].x), a2 = lo16(xr[i][jj].y), a3 = hi16(xr[i][jj].y); ss += (a0 * a0 + a1 * a1) + (a2 * a2 + a3 * a3); }
            const float r = 1.0f / sqrtf(wave_sum(ss) * (1.0f / DM) + EPS);
#pragma unroll
            for (int jj = 0; jj < 8; ++jj) {
                const f32x4 a = (f32x4){lo16(xr[i][jj].x), hi16(xr[i][jj].x), lo16(xr[i][jj].y), hi16(xr[i][jj].y)} * r * gq[jj];
                *(unsigned*)(XN8 + (size_t)m * DM + 4 * C.lane + 256 * jj) = pk4_fp8(a.x * pg8::SC_X, a.y * pg8::SC_X, a.z * pg8::SC_X, a.w * pg8::SC_X);
                u32x2 o; o.x = pk2(a.x, a.y); o.y = pk2(a.z, a.w);
                *(LAS u32x2*)(T + (4 * C.wave + i) * RS + (4 * C.lane + 256 * jj) * 2) = o;
            }
        }
        if (p == 0) {
#pragma unroll
            for (int i = 0; i < 4; ++i)
#pragma unroll
                for (int jj = 0; jj < 8; ++jj) xr[i][jj] = *(const u32x2*)(X + (size_t)(C.rb + (4 + i) * C.rs) * DM + 4 * C.lane + 256 * jj);
        }
        LDS_WAIT(); __syncthreads();
        f32x4 acc0 = {0.f, 0.f, 0.f, 0.f}, acc1 = {0.f, 0.f, 0.f, 0.f};
#pragma unroll
        for (int s2 = 0; s2 < 8; ++s2) {
            const bf16x8 a0 = *(const LAS bf16x8*)(T + l15 * RS + (256 * C.wave + 32 * s2 + 8 * kq) * 2), a1 = *(const LAS bf16x8*)(T + (16 + l15) * RS + (256 * C.wave + 32 * s2 + 8 * kq) * 2);
            acc0 = __builtin_amdgcn_mfma_f32_16x16x32_bf16(a0, bhi[s2], acc0, 0, 0, 0); acc0 = __builtin_amdgcn_mfma_f32_16x16x32_bf16(a0, blo[s2], acc0, 0, 0, 0);
            acc1 = __builtin_amdgcn_mfma_f32_16x16x32_bf16(a1, bhi[s2], acc1, 0, 0, 0); acc1 = __builtin_amdgcn_mfma_f32_16x16x32_bf16(a1, blo[s2], acc1, 0, 0, 0);
        }
#pragma unroll
        for (int rg = 0; rg < 4; ++rg) { PART[(C.wave * 32 + 4 * kq + rg) * NE + l15] = acc0[rg]; PART[(C.wave * 32 + 16 + 4 * kq + rg) * NE + l15] = acc1[rg]; }
        LDS_WAIT(); __syncthreads();
        {   const int row = C.tid >> 4, e = C.tid & 15;
            float lg = 0.f;
#pragma unroll
            for (int w = 0; w < 8; ++w) lg += PART[(w * 32 + row) * NE + e];
            float mx = lg; mx = fmaxf(mx, __shfl_xor(mx, 1)); mx = fmaxf(mx, __shfl_xor(mx, 2)); mx = fmaxf(mx, __shfl_xor(mx, 4)); mx = fmaxf(mx, __shfl_xor(mx, 8));
            const float ex = __expf(lg - mx); float se = ex; se += __shfl_xor(se, 1); se += __shfl_xor(se, 2); se += __shfl_xor(se, 4); se += __shfl_xor(se, 8);
            const int m = (C.rb - C.wave) + (row >> 2) + (4 * p + (row & 3)) * C.rs;
            AFFT[((size_t)(m >> 11) * NE + e) * SEQ + (m & (SEQ - 1))] = ex / se; }
    }
}

__device__ __forceinline__ unsigned wave_cnt4(bool f0, bool f1, bool f2, bool f3) {
    return (unsigned)(__builtin_popcountll(__ballot(f0)) + __builtin_popcountll(__ballot(f1)) + __builtin_popcountll(__ballot(f2)) + __builtin_popcountll(__ballot(f3)));
}
__device__ __forceinline__ unsigned lanes_below(bool f) { const unsigned long long m = __ballot(f); return __builtin_amdgcn_mbcnt_hi((unsigned)(m >> 32), __builtin_amdgcn_mbcnt_lo((unsigned)m, 0u)); }
__device__ __forceinline__ void rank_phase(const Ctx& C) {
    LAS unsigned* CN = (LAS unsigned*)C.lds;
    const float* AFFT = WSP(float, WS_AFFT); int* IDX = WSP(int, WS_IDX); float* GATE = WSP(float, WS_IDX + 512 * 1024); int* SEL = WSP(int, WS_SEL);
    const int u0 = (C.G == 256) ? (((int)blockIdx.x >> 3) < NE ? ((int)blockIdx.x & 7) * NE + ((int)blockIdx.x >> 3) : NB * NE) : (int)blockIdx.x;
    if (C.G == 256 && ((int)blockIdx.x >> 3) == NE && C.tid == 0) { __builtin_amdgcn_fence(__ATOMIC_RELEASE, "agent"); asm volatile("s_waitcnt vmcnt(0)" ::: "memory"); }
    for (int u = u0; u < NB * NE; u += C.G) {
        const int b = u >> 4, e = u & 15;
        __syncthreads();
        if (C.tid < 64) CN[C.tid] = 0u;
        const f32x4 av = ((const f32x4*)(AFFT + (size_t)(b * NE + e) * SEQ))[C.tid];
        const unsigned k0 = __float_as_uint(av.x), k1 = __float_as_uint(av.y), k2 = __float_as_uint(av.z), k3 = __float_as_uint(av.w);
        LDS_WAIT(); __syncthreads();
        unsigned T = 0u;
        for (int bit = 29; bit >= 0; --bit) {
            const unsigned cand = T | (1u << bit);
            const unsigned ws = wave_cnt4(k0 >= cand, k1 >= cand, k2 >= cand, k3 >= cand);
            if (C.lane == 0) __hip_atomic_fetch_add(CN + bit, ws, __ATOMIC_RELAXED, __HIP_MEMORY_SCOPE_WORKGROUP);
            LDS_WAIT(); __syncthreads();
            if (CN[bit] >= (unsigned)CAP) T = cand;
        }
        { const unsigned ws = wave_cnt4(k0 > T, k1 > T, k2 > T, k3 > T);
          if (C.lane == 0) __hip_atomic_fetch_add(CN + 30, ws, __ATOMIC_RELAXED, __HIP_MEMORY_SCOPE_WORKGROUP); }
        const bool q0 = k0 == T, q1 = k1 == T, q2 = k2 == T, q3 = k3 == T;
        const unsigned qpre = lanes_below(q0) + lanes_below(q1) + lanes_below(q2) + lanes_below(q3);
        { const unsigned wt = wave_cnt4(q0, q1, q2, q3); if (C.lane == 0) CN[32 + C.wave] = wt; }
        LDS_WAIT(); __syncthreads();
        const unsigned need = (unsigned)CAP - CN[30];
        unsigned qb = qpre;
#pragma unroll
        for (int w = 0; w < 8; ++w) qb += (w < C.wave) ? CN[32 + w] : 0u;
        const bool s0 = k0 > T || (q0 && qb < need);
        const bool s1 = k1 > T || (q1 && qb + (q0 ? 1u : 0u) < need);
        const bool s2 = k2 > T || (q2 && qb + (q0 ? 1u : 0u) + (q1 ? 1u : 0u) < need);
        const bool s3 = k3 > T || (q3 && qb + (q0 ? 1u : 0u) + (q1 ? 1u : 0u) + (q2 ? 1u : 0u) < need);
        const unsigned spre = lanes_below(s0) + lanes_below(s1) + lanes_below(s2) + lanes_below(s3);
        { const unsigned wt = wave_cnt4(s0, s1, s2, s3); if (C.lane == 0) CN[40 + C.wave] = wt; }
        LDS_WAIT(); __syncthreads();
        unsigned sb = spre;
#pragma unroll
        for (int w = 0; w < 8; ++w) sb += (w < C.wave) ? CN[40 + w] : 0u;
        const int t0 = 4 * C.tid, row0 = b * SEQ + t0, ob = (e * NB + b) * CAP;
        const unsigned p0 = sb, p1 = p0 + (s0 ? 1u : 0u), p2 = p1 + (s1 ? 1u : 0u), p3 = p2 + (s2 ? 1u : 0u);
        if (s0) { IDX[ob + p0] = row0;     GATE[ob + p0] = av.x; }
        if (s1) { IDX[ob + p1] = row0 + 1; GATE[ob + p1] = av.y; }
        if (s2) { IDX[ob + p2] = row0 + 2; GATE[ob + p2] = av.z; }
        if (s3) { IDX[ob + p3] = row0 + 3; GATE[ob + p3] = av.w; }
        SEL[(size_t)(row0 + 0) * NE + e] = s0 ? (int)p0 : -1; SEL[(size_t)(row0 + 1) * NE + e] = s1 ? (int)p1 : -1;
        SEL[(size_t)(row0 + 2) * NE + e] = s2 ? (int)p2 : -1; SEL[(size_t)(row0 + 3) * NE + e] = s3 ? (int)p3 : -1;
    }
}

template <bool FINAL>
__device__ __forceinline__ void combine_phase(const Ctx& C, bf16_t* X, const float* g, float* OUT) {
    const int* SEL = WSP(int, WS_SEL); const unsigned char* Y = WSP(unsigned char, WS_Y); unsigned char* XN = WSP(unsigned char, WS_XN8);
    int cc[2][2];
#pragma unroll
    for (int j = 0; j < 2; ++j) { const int q = C.lane + 64 * j; cc[j][0] = (q >> 4) * 256 + (q & 15) * 8; cc[j][1] = cc[j][0] + 128; }
    int svn = -1; u32x4 xn[2][2]; f32x4 gq[2][2][2];
#pragma unroll
    for (int j = 0; j < 2; ++j)
#pragma unroll
        for (int k = 0; k < 2; ++k) { gq[j][k][0] = *(const f32x4*)(g + cc[j][k]); gq[j][k][1] = *(const f32x4*)(g + cc[j][k] + 4); }
    if (C.rb < C.re) { svn = C.lane < NE ? SEL[(size_t)C.rb * NE + C.lane] : -1;
#pragma unroll
        for (int j = 0; j < 2; ++j)
#pragma unroll
            for (int k = 0; k < 2; ++k) xn[j][k] = *(const u32x4*)(X + (size_t)C.rb * DM + cc[j][k]); }
    for (int m = C.rb; m < C.re; m += C.rs) {
        const int sv = svn;
        unsigned long long mask = __ballot(sv >= 0);
        bf16_t* xr = X + (size_t)m * DM;
        f32x4 v[2][2][2];
#pragma unroll
        for (int j = 0; j < 2; ++j)
#pragma unroll
            for (int k = 0; k < 2; ++k) { const u32x4 y = xn[j][k];
                v[j][k][0] = (f32x4){lo16(y.x), hi16(y.x), lo16(y.y), hi16(y.y)}; v[j][k][1] = (f32x4){lo16(y.z), hi16(y.z), lo16(y.w), hi16(y.w)}; }
        { const int mn = (m + C.rs < C.re) ? m + C.rs : m;
          svn = C.lane < NE ? SEL[(size_t)mn * NE + C.lane] : -1;
#pragma unroll
          for (int j = 0; j < 2; ++j)
#pragma unroll
              for (int k = 0; k < 2; ++k) xn[j][k] = *(const u32x4*)(X + (size_t)mn * DM + cc[j][k]); }
        const int b = m >> 11;
        while (mask) {
            const int e = __builtin_ctzll(mask); mask &= mask - 1;
            const int slot = __builtin_amdgcn_readlane(sv, e);
            const unsigned char* yr = Y + (size_t)(e * ER + b * CAP + slot) * DM + 16 * C.lane;
#pragma unroll
            for (int j = 0; j < 2; ++j) { const u32x4 y = __builtin_nontemporal_load((const u32x4*)(yr + 1024 * j));
                v[j][0][0] += up4_fp8(y.x) * Y_INV; v[j][0][1] += up4_fp8(y.y) * Y_INV; v[j][1][0] += up4_fp8(y.z) * Y_INV; v[j][1][1] += up4_fp8(y.w) * Y_INV; }
        }
        float ss = 0.f;
#pragma unroll
        for (int j = 0; j < 2; ++j)
#pragma unroll
            for (int k = 0; k < 2; ++k)
#pragma unroll
                for (int q = 0; q < 2; ++q) ss += (v[j][k][q].x * v[j][k][q].x + v[j][k][q].y * v[j][k][q].y) + (v[j][k][q].z * v[j][k][q].z + v[j][k][q].w * v[j][k][q].w);
        const float r = 1.0f / sqrtf(wave_sum(ss) * (1.0f / DM) + EPS);
#pragma unroll
        for (int j = 0; j < 2; ++j)
#pragma unroll
            for (int k = 0; k < 2; ++k) {
                const f32x4 a = v[j][k][0] * r * gq[j][k][0], bb = v[j][k][1] * r * gq[j][k][1];
                if (FINAL) { float* orow = OUT + (size_t)m * DM + cc[j][k]; __builtin_nontemporal_store(a, (f32x4*)orow); __builtin_nontemporal_store(bb, (f32x4*)(orow + 4)); }
                else { u32x4 xo; xo.x = pk2(v[j][k][0].x, v[j][k][0].y); xo.y = pk2(v[j][k][0].z, v[j][k][0].w); xo.z = pk2(v[j][k][1].x, v[j][k][1].y); xo.w = pk2(v[j][k][1].z, v[j][k][1].w);
                    *(u32x4*)(xr + cc[j][k]) = xo;
                    u32x2 o; o.x = pk4_fp8(a.x * 8.0f, a.y * 8.0f, a.z * 8.0f, a.w * 8.0f); o.y = pk4_fp8(bb.x * 8.0f, bb.y * 8.0f, bb.z * 8.0f, bb.w * 8.0f);
                    *(u32x2*)(XN + (size_t)m * DM + cc[j][k]) = o; }
            }
    }
}

struct Args { const void* in[19]; float* out; unsigned char* ws; int ph_lo, ph_hi; };
constexpr int NPHASE = 18;

__global__ void __launch_bounds__(NTHR, 2) mk_fwd(Args args) {
    extern __shared__ __attribute__((aligned(16))) unsigned char lds_raw[];
    Ctx C;
    C.lds = (LAS unsigned char*)lds_raw;
    C.tid = threadIdx.x; C.lane = C.tid & 63; C.wave = __builtin_amdgcn_readfirstlane(C.tid >> 6);
    C.G = gridDim.x; C.gw = blockIdx.x * NWAVES + C.wave; C.NGW = C.G * NWAVES;
    if (C.G == 256) { const int v = (int)blockIdx.x & 7, lr = (int)blockIdx.x >> 3; C.rb = v * SEQ + lr * NWAVES + C.wave; C.rs = 32 * NWAVES; C.re = (v + 1) * SEQ; }
    else { C.rb = C.gw; C.rs = C.NGW; C.re = M; }
    C.ws = args.ws; C.ctl = (gu32*)(args.ws + WS_CTL);
#define INF(k) ((const float*)args.in[k])
    volatile LAS unsigned* MISC = (volatile LAS unsigned*)(C.lds + MISC_OFF);
    LAS int* tab = (LAS int*)(C.lds + TAB_OFF);
    for (int u = C.tid; u < 64; u += NTHR) ((LAS unsigned*)(C.lds + MISC_OFF))[u] = 0u;
    __syncthreads();
    XcdBarrier bar; bar.bar = (unsigned*)(C.ctl + CW_BAR); bar.x = 0; bar.st = nullptr;
#if !MK_PER_PHASE
    bar = xcd_barrier_post((unsigned*)(C.ctl + CW_BAR), MISC + 8);
#define GRID_BAR() xcd_barrier(bar)
#define LOCAL_BAR() do { if (lok) { lgen += 32u; xcd_local_barrier(bar, lgen); } else xcd_barrier(bar); } while (0)
    if (C.tid == 0 && (xb_xcc_id() != (blockIdx.x & 7u) || gridDim.x != 256u)) atomicAdd(&bar.bar[XB_BAD], 1u);
#else
#define GRID_BAR() do {} while (0)
#define LOCAL_BAR() do {} while (0)
#endif
    bool lok = false; unsigned lgen = 0u;
    const int lo = args.ph_lo, hi = args.ph_hi;
#ifndef PHASE_MASK
#define PHASE_MASK 0x3ffff
#endif
#define IN(k) (((PHASE_MASK >> (k)) & 1) && lo <= (k) && (k) < hi)
#ifndef REP_MASK
#define REP_MASK 0x0
#endif
#define REPS(k) for (int rep_ = 0; rep_ < (((REP_MASK >> (k)) & 1) ? 2 : 1); ++rep_)
#define SEAM(k) do { if (IN(k) && IN((k) + 1)) GRID_BAR(); } while (0)
#define SEAM_L(k) do { if (IN(k) && IN((k) + 1)) LOCAL_BAR(); } while (0)
    const int cidx = (int)blockIdx.x;
    const int uidx = (C.G == 256) ? (cidx & 7) * 32 + (cidx >> 3) : cidx;
    const unsigned char* XN8 = WSP(unsigned char, WS_XN8); bf16_t* PROJ = WSP(bf16_t, WS_PROJ); bf16_t* CAT = WSP(bf16_t, WS_CAT);
    bf16_t* X = WSP(bf16_t, WS_XB);

    if (IN(0)) REPS(0) { p0_prologue(C, INF(16), INF(17), INF(18), INF(7), INF(8), INF(11), INF(14), INF(12), INF(9), INF(0), INF(3), INF(1), INF(5), (const int*)args.in[2], INF(10), INF(15)); } SEAM(0);
#if !MK_PER_PHASE
    if (IN(0) && IN(1)) { if (C.tid == 0) MISC[24] = xb_ld(&bar.bar[XB_BAD]); __syncthreads(); lok = __builtin_amdgcn_readfirstlane((int)MISC[24]) == 0; }
#endif
    if (IN(1)) REPS(1) {
        const bool part = (C.G == 256); const int q8 = cidx >> 3;
        const bool conv = part && ((q8 & 3) == 3);
        const int ci = (q8 >> 2) * 8 + (cidx & 7), gi = ((q8 >> 2) * 3 + (q8 & 3)) * 8 + (cidx & 7);
        pg8::ProbDense p{WSP(bf16_t, WS_XN), WSP(bf16_t, WS_WPIN), PROJ, 64, 8, DM, WSP(bf16_t, WS_MEMN), WSP(bf16_t, WS_WMEMKV), WSP(bf16_t, WS_MEMKV), 8, 8, DM, 32, DM, DM, part ? 192 : C.G, part ? (conv ? -1 : gi) : cidx};
        pg8::gemm_phase(C.lds, tab, p);
        { pg8::ProbFold pf{WSP(bf16_t, WS_WPOUT), WSP(bf16_t, WS_WGRP), WSP(bf16_t, WS_WPOUT2), 6, DM, 384, C.G, part ? (conv ? ci : -1) : (C.G >= 128 ? cidx - 64 : cidx)}; pg8::gemm_phase(C.lds, tab, pf); }
        if (part) { if (conv) expert_slot(C, ci * CONV1_N, CONV1_N, INF(16), INF(17), INF(18)); }
        else expert_items(IT_EXP - IT_MOVED + C.gw, C.NGW, IT_EXP - IT_MOVED + SLOT1_ITEMS, INF(16), INF(17), INF(18), C.ws, C.lane);
    } SEAM(1);
    if (IN(2)) REPS(2) {
        down_items((C.G == 256 ? 2 * C.NGW : 0) + C.gw, C.NGW, NE * 512, INF(18), C.ws, C.lane);
        for (int u = uidx; u < 256; u += C.G) xattn_unit<false, 2>(C, u, PROJ, DM, TOK, 0, C.gw + C.NGW < NE * 512 ? C.gw : 0, C.gw + C.NGW < NE * 512 ? C.NGW : 0, INF(18));
        pool_phase(C);
    } do { if (IN(2) && IN(4)) LOCAL_BAR(); } while (0);
    if (IN(4)) REPS(4) { pg8::ProbOut<true> p{CAT, WSP(bf16_t, WS_WPOUT2), WSP(bf16_t, WS_XN), X, WSP(float, WS_RINV), INF(3), 32, DM, DM, C.G, cidx}; pg8::gemm_phase(C.lds, tab, p); } SEAM_L(4);
#define MOE_PHASES(layer, pb) do { \
        if (IN(pb)) REPS(pb) { if (C.G == 256) router_phase_mfma(C, X, INF(4) + (layer) * DM, WSP(bf16_t, WS_WRT) + (size_t)(layer) * 2 * NE * DM); else router_phase(C, X, INF(4) + (layer) * DM, INF(15) + (size_t)(layer) * DM * NE); } SEAM_L(pb); \
        if (IN((pb) + 1)) REPS((pb) + 1) { rank_phase(C); } SEAM((pb) + 1); \
        if (IN((pb) + 2)) REPS((pb) + 2) { pg8::ProbGU p{WSP(unsigned char, WS_XN8), WSP(unsigned char, WS_WGU) + (size_t)(layer) * NE * DM * DM, WSP(int, WS_IDX), WSP(bf16_t, WS_HACT), 16, DM, DM, C.G, cidx}; pg8::gemm_phase(C.lds, tab, p); } SEAM_L((pb) + 2); \
        if (IN((pb) + 3)) REPS((pb) + 3) { pg8::ProbDN p{WSP(bf16_t, WS_HACT), (const bf16_t*)(WSP(unsigned char, WS_WDN) + (size_t)(layer) * NE * DM * DE), WSP(float, WS_IDX + 512 * 1024), WSP(bf16_t, WS_Y), 8, DE, DE, C.G, cidx}; pg8::gemm_phase(C.lds, tab, p); } SEAM((pb) + 3); \
    } while (0)
    MOE_PHASES(0, 5);
    if (IN(9)) { combine_phase<false>(C, X, INF(3) + DM, args.out); } SEAM_L(9);
    if (IN(10)) REPS(10) {
        const bool part = (C.G == 256); const int q8 = cidx >> 3;
        const bool conv = part && (q8 & 7) >= 5;
        const int ci = ((q8 >> 3) * 3 + (q8 & 7) - 5) * 8 + (cidx & 7), gi = ((q8 >> 3) * 5 + (q8 & 7)) * 8 + (cidx & 7);
        pg8::ProbDense8 p{XN8, WSP(unsigned char, WS_WAIN), PROJ, 64, 10, AINP, nullptr, nullptr, nullptr, 0, 0, 0, 16, DM, DM, part ? 160 : C.G, part ? (conv ? -1 : gi) : cidx};
        pg8::gemm_phase(C.lds, tab, p);
        if (part) { if (conv) { expert_slot(C, SLOT1_ITEMS + ci * CONV2_N, CONV2_N, INF(16), INF(17), INF(18)); down_items(NE * 512 + ci * DN10_N + C.wave, NWAVES, NE * 512 + (ci + 1) * DN10_N, INF(18), C.ws, C.lane); } }
        else expert_items(IT_EXP - IT_MOVED + SLOT1_ITEMS + C.gw, C.NGW, IT_EXP, INF(16), INF(17), INF(18), C.ws, C.lane);
    } SEAM_L(10);
    if (IN(11)) REPS(11) {
        if (C.G != 256) down_items(NE * 512 + C.gw, C.NGW, 2 * NE * 512, INF(18), C.ws, C.lane);
#pragma unroll 1
        for (int k = 0; k < 3; ++k) { const int u = uidx * 3 + k; int di = NE * 512 + DN10_ITEMS + C.gw + k * C.NGW; if (C.G != 256 || di >= 2 * NE * 512) di = 2 * NE * 512 - 1 - C.wave;
            if (u < 768) wattn_unit(C, u, INF(13), di, INF(18)); }
        if (C.G < 256) for (int u = C.G * 3 + cidx; u < 768; u += C.G) wattn_unit(C, u, INF(13), 2 * NE * 512 - 1 - C.wave, INF(18));
        { Ctx C2 = C; asm volatile("" : "+v"(C2.tid), "+v"(C2.lane));
          int dx = NE * 512 + DN10_ITEMS + C.gw + 3 * C.NGW; if (C.G != 256 || dx >= 2 * NE * 512) dx = 2 * NE * 512 - 1 - C.wave;
          for (int u = uidx; u < 256; u += C.G) xattn_unit<true, 1>(C2, u, PROJ, AINP, TOK + 2 * KVW, 1024, dx, 0, INF(18)); }
    } SEAM_L(11);
    if (IN(12)) { pg8::ProbOut8 p{WSP(unsigned char, WS_CAT), WSP(unsigned char, WS_WAOUT), X, 16, DM, DM, C.G, cidx}; pg8::gemm_phase(C.lds, tab, p); } SEAM_L(12);
    MOE_PHASES(1, 13);
    if (IN(17)) { combine_phase<true>(C, X, INF(6), args.out); }
#undef IN
#undef SEAM
#undef SEAM_L
}

extern "C" void kernel_launch(void* const* d_in, const int* in_sizes, int n_in, void* d_out, int out_size, void* d_ws, size_t ws_size, hipStream_t stream) {
    static int grid = 0;
    if (grid == 0) {
        if (n_in != 19 || out_size != M * DM || ws_size < WS_END) { fprintf(stderr, "kernel_launch: unexpected shapes (n_in %d, out %d, ws %zu < %zu); nothing launched\n", n_in, out_size, ws_size, (size_t)WS_END); grid = -1; return; }
        int dev = 0, cus = 0, per_cu = 0;
        if (hipGetDevice(&dev) != hipSuccess || hipDeviceGetAttribute(&cus, hipDeviceAttributeMultiprocessorCount, dev) != hipSuccess) { fprintf(stderr, "kernel_launch: device query failed\n"); grid = -1; return; }
        if (hipFuncSetAttribute((const void*)mk_fwd, hipFuncAttributeMaxDynamicSharedMemorySize, LDS_BYTES) != hipSuccess) { fprintf(stderr, "kernel_launch: hipFuncSetAttribute failed\n"); grid = -1; return; }
        if (hipOccupancyMaxActiveBlocksPerMultiprocessor(&per_cu, (const void*)mk_fwd, NTHR, LDS_BYTES) != hipSuccess || per_cu < 1)
            fprintf(stderr, "kernel_launch: note: occupancy query reports %d workgroups per CU\n", per_cu);
        (void)hipGetLastError();
        grid = cus;
        if (grid != 256) fprintf(stderr, "kernel_launch: note: %d CUs (tuned for 256)\n", grid);
    }
    if (grid < 0) return;
    if (hipMemsetAsync((char*)d_ws + WS_CTL, 0, CTL_ZERO_BYTES, stream) != hipSuccess) { fprintf(stderr, "kernel_launch: hipMemsetAsync failed\n"); return; }
    Args a{};
    for (int i = 0; i < 19; ++i) a.in[i] = d_in[i];
    a.out = (float*)d_out; a.ws = (unsigned char*)d_ws;
#if MK_PER_PHASE
    for (int ph = 0; ph < NPHASE; ++ph) { a.ph_lo = ph; a.ph_hi = ph + 1; hipLaunchKernelGGL(mk_fwd, dim3(grid), dim3(NTHR), LDS_BYTES, stream, a); }
#else
    a.ph_lo = 0; a.ph_hi = NPHASE;
    hipLaunchKernelGGL(mk_fwd, dim3(grid), dim3(NTHR), LDS_BYTES, stream, a);
#endif
    const hipError_t le = hipPeekAtLastError();
    if (le != hipSuccess) fprintf(stderr, "kernel_launch: launch failed: %s\n", hipGetErrorName(le));
}
```

```cpp
#include <hip/hip_runtime.h>
#include <cstdio>
#include <cstdint>

#ifndef MK_PER_PHASE
#define MK_PER_PHASE 0
#endif

#define LAS __attribute__((address_space(3)))
#define GAS __attribute__((address_space(1)))
typedef unsigned short bf16_t;
typedef short bf16x8 __attribute__((ext_vector_type(8)));
typedef short s16x4 __attribute__((ext_vector_type(4)));
typedef float f32x2 __attribute__((ext_vector_type(2)));
typedef float f32x4 __attribute__((ext_vector_type(4)));
typedef float f32x16 __attribute__((ext_vector_type(16)));
typedef unsigned u32x2 __attribute__((ext_vector_type(2)));
typedef unsigned u32x4 __attribute__((ext_vector_type(4)));
typedef __bf16 bf16x2_t __attribute__((ext_vector_type(2)));
typedef GAS unsigned gu32;

constexpr int NB = 8, SEQ = 2048, DM = 2048, M = NB * SEQ, MEML = 256, MR = NB * MEML;
constexpr int TOK = 1536, XAW = 512, KVW = 192, AIN = 2432, AINP = 2560;
constexpr int NE = 16, CAP = 256, DE = 1024, ER = NB * CAP;
constexpr float EPS = 1e-6f;
constexpr float LOG2E = 1.4426950408889634f;

constexpr size_t MiB = 1u << 20;
constexpr size_t WS_CTL = 0, CTL_ZERO_BYTES = 1 * MiB;
constexpr size_t WS_WMEMKV = 1 * MiB;
constexpr size_t WS_WPIN = 9 * MiB;
constexpr size_t WS_WPOUT = 17 * MiB;
constexpr size_t WS_WGRP = 25 * MiB;
constexpr size_t WS_WAIN = 27 * MiB;
constexpr size_t WS_WAOUT = 37 * MiB;
constexpr size_t WS_WGU = 45 * MiB;
constexpr size_t WS_XN8 = 173 * MiB;
constexpr size_t WS_WDN = 301 * MiB;
constexpr size_t WS_XN = 429 * MiB;
constexpr size_t WS_MEMN = 493 * MiB;
constexpr size_t WS_MEMKV = 501 * MiB;
constexpr size_t WS_PROJ = 509 * MiB;
constexpr size_t WS_WPOUT2 = 589 * MiB;
constexpr size_t WS_CAT = 637 * MiB;
constexpr size_t WS_HACT = 701 * MiB;
constexpr size_t WS_Y = 765 * MiB;
constexpr size_t WS_AFFT = 893 * MiB;
constexpr size_t WS_IDX = 894 * MiB;
constexpr size_t WS_WRT = 894 * MiB + 256 * 1024;
constexpr size_t WS_RINV = 894 * MiB + 768 * 1024;
constexpr size_t WS_SEL = 895 * MiB;
constexpr size_t WS_ROPE = 896 * MiB;
constexpr size_t WS_XB = 897 * MiB;
constexpr size_t WS_END = 961 * MiB;
constexpr int CW_BAR = 4096;

constexpr int RING_BYTES = 143360;
constexpr int TAB_OFF = RING_BYTES;
constexpr int MISC_OFF = TAB_OFF + 8192;
constexpr int LDS_BYTES = MISC_OFF + 256;
constexpr int NWAVES = 8, NTHR = 512;

#define LDS_WAIT() asm volatile("s_waitcnt lgkmcnt(0)" ::: "memory")
#define VM_WAIT() asm volatile("s_waitcnt vmcnt(0)" ::: "memory")
__device__ __forceinline__ float bf2f(bf16_t v) { return __uint_as_float(((unsigned)v) << 16); }
__device__ __forceinline__ unsigned pk2(float lo, float hi) { f32x2 v = {lo, hi}; bf16x2_t b = __builtin_convertvector(v, bf16x2_t); return __builtin_bit_cast(unsigned, b); }
__device__ __forceinline__ bf16_t f2bf(float f) { return (bf16_t)(pk2(f, 0.f) & 0xffffu); }
__device__ __forceinline__ float lo16(unsigned w) { return __uint_as_float(w << 16); }
__device__ __forceinline__ float hi16(unsigned w) { return __uint_as_float(w & 0xffff0000u); }
constexpr float Y_SCALE = 32.0f, Y_INV = 1.0f / 32.0f;
constexpr float SC_CAT = 16.0f, SC_WD8 = 64.0f;
__device__ __forceinline__ unsigned pk4_fp8(float a, float b, float c, float d) {
    a = __builtin_amdgcn_fmed3f(a, -448.f, 448.f); b = __builtin_amdgcn_fmed3f(b, -448.f, 448.f); c = __builtin_amdgcn_fmed3f(c, -448.f, 448.f); d = __builtin_amdgcn_fmed3f(d, -448.f, 448.f);
    int w = __builtin_amdgcn_cvt_pk_fp8_f32(a, b, 0, false); w = __builtin_amdgcn_cvt_pk_fp8_f32(c, d, w, true); return (unsigned)w;
}
__device__ __forceinline__ f32x4 up4_fp8(unsigned w) { const f32x2 lo = __builtin_amdgcn_cvt_pk_f32_fp8((int)w, false), hi = __builtin_amdgcn_cvt_pk_f32_fp8((int)w, true); return (f32x4){lo.x, lo.y, hi.x, hi.y}; }
__device__ __forceinline__ float wave_sum(float v) {
#pragma unroll
    for (int o = 1; o < 64; o <<= 1) v += __shfl_xor(v, o);
    return v;
}
__device__ __forceinline__ int crow(int r, int hi) { return (r & 3) + 8 * (r >> 2) + 4 * hi; }

#define XB_TMO      128
#define XB_XCNT(j)  (256  + 64 * (j))
#define XB_XSUB(j)  (1280 + 64 * (j))
#define XB_XGEN(j)  (2304 + 64 * (j))
#define XB_TOP      3328
#define XB_TOPGEN   3392
#define XCD_BAR_WORDS 3456
#define XB_SPIN_CAP (1u << 18)
__device__ __forceinline__ unsigned xb_ld(unsigned* p)              { return __hip_atomic_load(p, __ATOMIC_RELAXED, __HIP_MEMORY_SCOPE_AGENT); }
__device__ __forceinline__ unsigned xb_add(unsigned* p, unsigned v) { return __hip_atomic_fetch_add(p, v, __ATOMIC_RELAXED, __HIP_MEMORY_SCOPE_AGENT); }
__device__ __forceinline__ unsigned xb_xcc_id() { return (unsigned)__builtin_amdgcn_s_getreg((3 << 11) | 20) & 0xFu; }
#define XB_SPIN(cond, bar) do { unsigned _sp = 0; while (cond) { __builtin_amdgcn_s_sleep(1); \
    if ((++_sp & 255u) == 0u) { if (xb_ld(&(bar)[XB_TMO])) break; if (_sp > XB_SPIN_CAP) { atomicAdd(&(bar)[XB_TMO], 1u); break; } } } } while (0)
struct XcdBarrier { unsigned* bar; unsigned x; volatile LAS unsigned* st; };
__device__ __forceinline__ XcdBarrier xcd_barrier_post(unsigned* bar, volatile LAS unsigned* st) {
    XcdBarrier b; b.bar = bar; b.x = xb_xcc_id(); b.st = st;
    if (threadIdx.x == 0) (void)xb_add(&bar[XB_XCNT(b.x)], 1u);
    return b;
}
__device__ __forceinline__ void xcd_barrier_complete(unsigned* bar, unsigned x, unsigned& nloc, unsigned& nx) {
    const unsigned G = gridDim.x * gridDim.y * gridDim.z;
    unsigned sum, cnt, mine, sp = 0u;
    for (;;) {
        sum = 0u; cnt = 0u; mine = 0u;
#pragma unroll
        for (unsigned j = 0; j < 16; ++j) { const unsigned c = xb_ld(&bar[XB_XCNT(j)]); sum += c; cnt += (c > 0u) ? 1u : 0u; mine = (j == x) ? c : mine; }
        if (sum == G) break;
        __builtin_amdgcn_s_sleep(1);
        if ((++sp & 255u) == 0u) { if (xb_ld(&bar[XB_TMO])) break; if (sp > XB_SPIN_CAP) { atomicAdd(&bar[XB_TMO], 1u); break; } }
    }
    nloc = mine > 0u ? mine : 1u; nx = cnt > 0u ? cnt : 1u;
}
__device__ __forceinline__ void xcd_barrier(const XcdBarrier& b) {
    asm volatile("s_waitcnt vmcnt(0)" ::: "memory");
    __syncthreads();
    if (threadIdx.x == 0) {
        unsigned* bar = b.bar;
        __builtin_amdgcn_s_waitcnt(0);
        unsigned nloc = b.st[0], nx = b.st[1];
        if (nloc == 0u) { xcd_barrier_complete(bar, b.x, nloc, nx); b.st[0] = nloc; b.st[1] = nx; }
        const unsigned old = xb_add(&bar[XB_XSUB(b.x)], 1u);
        const unsigned gen = old / nloc;
        if (old + 1u == (gen + 1u) * nloc) {
            __builtin_amdgcn_fence(__ATOMIC_RELEASE, "agent");
            asm volatile("s_waitcnt vmcnt(0)" ::: "memory");
            const unsigned og = xb_add(&bar[XB_TOP], 1u);
            const unsigned tg = og / nx;
            if (og + 1u == (tg + 1u) * nx) xb_add(&bar[XB_TOPGEN], 1u);
            else XB_SPIN(xb_ld(&bar[XB_TOPGEN]) == tg, bar);
            xb_add(&bar[XB_XGEN(b.x)], 1u);
            __builtin_amdgcn_fence(__ATOMIC_ACQUIRE, "agent");
            asm volatile("s_waitcnt vmcnt(0)" ::: "memory");
        } else {
            XB_SPIN(xb_ld(&bar[XB_XGEN(b.x)]) == gen, bar);
            __builtin_amdgcn_fence(__ATOMIC_ACQUIRE, "agent");
            asm volatile("s_waitcnt vmcnt(0)" ::: "memory");
        }
    }
    __syncthreads();
}

#define XB_LCNT(j)  (4096 + 64 * (j))
#define XB_BAD      6144
__device__ __forceinline__ void xcd_local_barrier(const XcdBarrier& b, unsigned target, bool acq) {
    asm volatile("s_waitcnt vmcnt(0)" ::: "memory");
    __syncthreads();
    if (threadIdx.x == 0) {
        unsigned* bar = b.bar;
        __builtin_amdgcn_s_waitcnt(0);
        (void)xb_add(&bar[XB_LCNT(b.x)], 1u);
        XB_SPIN(xb_ld(&bar[XB_LCNT(b.x)]) < target, bar);
        if (acq) { __builtin_amdgcn_fence(__ATOMIC_ACQUIRE, "agent"); asm volatile("s_waitcnt vmcnt(0)" ::: "memory"); }
    }
    __syncthreads();
}

namespace pg8 {
constexpr int BM = 256, BK = 64, HALF = 128, HTB = HALF * BK * 2;
__device__ __forceinline__ int lds_byte(int r, int c) { const int st = (r >> 4) * 2 + (c >> 5), rr = r & 15, cc = c & 31, ob = rr * 64 + cc * 2; return st * 1024 + (ob ^ (((ob >> 9) & 1) << 5)); }
__device__ __forceinline__ void stage_rc(int b, int& R, int& C) { const int st = b / 1024, sb = b % 1024, swz = sb ^ (((sb >> 9) & 1) << 5); R = (st >> 1) * 16 + swz / 64; C = (st & 1) * 32 + (swz % 64) / 2; }
__device__ __forceinline__ int perm32(int rho) { const int n = rho >> 4, i = rho & 15; return 8 * (i >> 2) + 4 * n + (i & 3); }
struct Unit { int pm, pn, e; };
typedef int i32x8 __attribute__((ext_vector_type(8)));
typedef int i32x4 __attribute__((ext_vector_type(4)));
__device__ __forceinline__ i32x8 cat8(bf16x8 a, bf16x8 b) { const i32x4 x = __builtin_bit_cast(i32x4, a), y = __builtin_bit_cast(i32x4, b); return (i32x8){x[0], x[1], x[2], x[3], y[0], y[1], y[2], y[3]}; }
typedef f32x4 Acc[2][2][4][2];
__device__ __forceinline__ void xcd_tile(int L, int nM, int nN, int& pm, int& pn) {
    const int nwg = nM * nN; int wgid = L; { const int q = nwg / 8, r = nwg % 8, xcd = wgid % 8, off = wgid / 8; wgid = (xcd < r ? xcd * (q + 1) : r * (q + 1) + (xcd - r) * q) + off; }
    const int nig = 8 * nN, gid = wgid / nig, fm = gid * 8, gsz = (nM - fm) < 8 ? (nM - fm) : 8;
    pm = fm + ((wgid % nig) % gsz); pn = (wgid % nig) / gsz;
}

template <class P>
__device__ __forceinline__ void gemm_phase(LAS unsigned char* lds, LAS int* tab, const P& p) {
    const int tid = threadIdx.x, wid = __builtin_amdgcn_readfirstlane(tid >> 6), lane = tid & 63, wr = wid >> 2, wc = wid & 3, fr = lane & 15, fq = lane >> 4;
    const int nt = p.nt;
    Unit cur, nxt; int ui = 0;
    if (!p.next(0, cur)) return;
    if constexpr (P::GATHER) { Unit tu; for (int i = 0; p.next(i, tu); ++i) p.fill_tab(tab, i, tu, tid); LDS_WAIT(); __syncthreads(); }
    int R_[2], C_[2]; unsigned voffB[2];
#pragma unroll
    for (int i = 0; i < 2; ++i) { int R, C; stage_rc(tid * 16 + i * 8192, R, C); R_[i] = R; C_[i] = C; const int Rb = P::PERM ? ((R & ~31) + perm32(R & 31)) : R; voffB[i] = (unsigned)(Rb * p.ldb) * (unsigned)P::ESZ + (unsigned)C * 2u; }
    unsigned voffA0[2], voffA1[2];
#define PG8_SETA(U, UI) do { if constexpr (P::GATHER_A) { _Pragma("unroll") for (int _i = 0; _i < 2; ++_i) { voffA0[_i] = p.a_rowoff(U, UI, R_[_i], tab) + (unsigned)C_[_i] * 2u; voffA1[_i] = p.a_rowoff(U, UI, R_[_i] + HALF, tab) + (unsigned)C_[_i] * 2u; } } } while (0)
    if constexpr (P::GATHER_A) { PG8_SETA(cur, 0); }
    else { _Pragma("unroll") for (int _i = 0; _i < 2; ++_i) { voffA0[_i] = p.a_rowoff(cur, 0, R_[_i], tab) + (unsigned)C_[_i] * 2u; voffA1[_i] = voffA0[_i]; } }
    const size_t hstepA = P::GATHER_A ? (size_t)0 : (size_t)p.a_rowoff(cur, 0, HALF, tab);
    const size_t kstep = (size_t)(BK * 2), hstepB = (size_t)HALF * p.ldb * P::ESZ;
    const unsigned ldsw = (unsigned)wid * 1024u;
    const int aoff = lds_byte(wr * 64 + fr, fq * 8), boff = lds_byte(wc * 32 + fr, fq * 8);
#define PG8_SA(b, h) (((b) * 2 + (h)) * HTB)
#define PG8_SB(b, h) ((4 + (b) * 2 + (h)) * HTB)
#define PG8_STAGE(bufoff, gbase, voff) do { _Pragma("unroll") for (int _i = 0; _i < 2; ++_i) \
        __builtin_amdgcn_global_load_lds((const unsigned*)((const char*)(gbase) + (voff)[_i]), (LAS unsigned*)(lds + (bufoff) + ldsw + _i * 8192), 16, 0, 0); } while (0)
#define PG8_LDA(dst, b, h) do { _Pragma("unroll") for (int m = 0; m < 4; ++m) _Pragma("unroll") for (int k = 0; k < 2; ++k) dst[m][k] = *(const LAS bf16x8*)(lds + PG8_SA(b, h) + aoff + m * 2048 + k * 1024); } while (0)
#define PG8_LDB(dst, b, h) do { _Pragma("unroll") for (int n = 0; n < 2; ++n) _Pragma("unroll") for (int k = 0; k < 2; ++k) dst[n][k] = *(const LAS bf16x8*)(lds + PG8_SB(b, h) + boff + n * 2048 + k * 1024); } while (0)
#define PG8_MMA(ai, bj, At, Bt) do { __builtin_amdgcn_s_setprio(1); \
        if constexpr (P::ESZ == 2) { _Pragma("unroll") for (int m = 0; m < 4; ++m) _Pragma("unroll") for (int n = 0; n < 2; ++n) _Pragma("unroll") for (int k = 0; k < 2; ++k) \
            acc[ai][bj][m][n] = __builtin_amdgcn_mfma_f32_16x16x32_bf16(Bt[n][k], At[m][k], acc[ai][bj][m][n], 0, 0, 0); } \
        else { _Pragma("unroll") for (int m = 0; m < 4; ++m) _Pragma("unroll") for (int n = 0; n < 2; ++n) \
            acc[ai][bj][m][n] = __builtin_amdgcn_mfma_scale_f32_16x16x128_f8f6f4(cat8(Bt[n][0], Bt[n][1]), cat8(At[m][0], At[m][1]), acc[ai][bj][m][n], 0, 0, 0, 0x7F7F7F7F, 0, 0x7F7F7F7F); } \
        __builtin_amdgcn_s_setprio(0); } while (0)
#define PG8_WAIT_V(n) asm volatile("s_waitcnt vmcnt(" #n ")" ::: "memory")
#define PG8_WAIT_L(n) asm volatile("s_waitcnt lgkmcnt(" #n ")" ::: "memory")
#define PG8_BAR __builtin_amdgcn_s_barrier()
#define PG8_SCHED __builtin_amdgcn_sched_barrier(0)
    Acc acc;
#pragma unroll
    for (int a = 0; a < 2; ++a)
#pragma unroll
        for (int b = 0; b < 2; ++b)
#pragma unroll
            for (int m = 0; m < 4; ++m)
#pragma unroll
                for (int n = 0; n < 2; ++n) acc[a][b][m][n] = (f32x4){0.f, 0.f, 0.f, 0.f};
    bf16x8 At[4][2], B0[2][2], B1[2][2];
    const char* cA = p.a_base(cur); const char* cB = p.b_base(cur);
    PG8_STAGE(PG8_SB(0, 0), cB, voffB); PG8_STAGE(PG8_SB(0, 1), cB + hstepB, voffB); PG8_STAGE(PG8_SA(0, 0), cA, voffA0); PG8_STAGE(PG8_SA(0, 1), cA + hstepA, voffA1);
    if (wr == 1) PG8_BAR;
    PG8_WAIT_V(2); PG8_BAR;
    PG8_STAGE(PG8_SB(1, 0), cB + kstep, voffB); PG8_STAGE(PG8_SB(1, 1), cB + hstepB + kstep, voffB);
    PG8_WAIT_V(4); PG8_BAR;
    for (;;) {
        const bool has_next = p.next(ui + 1, nxt);
        const char* nA = has_next ? p.a_base(nxt) : cA; const char* nB = has_next ? p.b_base(nxt) : cB;
#pragma unroll 1
        for (int t = 0; t < nt; t += 2) {
            const bool last = (t == nt - 2);
            const char* a1 = cA + (size_t)(t + 1) * kstep;
            const char* a2 = last ? nA : cA + (size_t)(t + 2) * kstep; const char* b2 = last ? nB : cB + (size_t)(t + 2) * kstep;
            const char* a3 = a2 + kstep; const char* b3 = b2 + kstep;
            PG8_LDB(B0, 0, 0); PG8_LDB(B1, 0, 1); PG8_SCHED; PG8_LDA(At, 0, 0); PG8_STAGE(PG8_SA(1, 1), a1 + hstepA, voffA1); PG8_STAGE(PG8_SA(1, 0), a1, voffA0);
            if (last && has_next) { PG8_SETA(nxt, ui + 1); }
            PG8_WAIT_V(10); PG8_WAIT_L(0); PG8_BAR; PG8_MMA(0, 0, At, B0); PG8_MMA(0, 1, At, B1); PG8_BAR; PG8_SCHED;
            PG8_LDA(At, 0, 1); PG8_STAGE(PG8_SB(0, 0), b2, voffB); PG8_STAGE(PG8_SB(0, 1), b2 + hstepB, voffB);
            PG8_WAIT_V(4); PG8_WAIT_L(0); PG8_BAR; PG8_MMA(1, 0, At, B0); PG8_MMA(1, 1, At, B1); PG8_BAR; PG8_SCHED;
            PG8_LDB(B0, 1, 0); PG8_LDB(B1, 1, 1); PG8_SCHED; PG8_LDA(At, 1, 0); PG8_STAGE(PG8_SA(0, 1), a2 + hstepA, voffA1); PG8_STAGE(PG8_SA(0, 0), a2, voffA0);
            PG8_WAIT_V(10); PG8_WAIT_L(0); PG8_BAR; PG8_MMA(0, 0, At, B0); PG8_MMA(0, 1, At, B1); PG8_BAR; PG8_SCHED;
            PG8_LDA(At, 1, 1); PG8_STAGE(PG8_SB(1, 0), b3, voffB); PG8_STAGE(PG8_SB(1, 1), b3 + hstepB, voffB);
            PG8_WAIT_V(4); PG8_WAIT_L(0); PG8_BAR; PG8_MMA(1, 0, At, B0); PG8_MMA(1, 1, At, B1); PG8_BAR; PG8_SCHED;
        }
        if (wr == 0) PG8_BAR;
        { int fr_ = fr, fq_ = fq; asm volatile("" : "+v"(fr_), "+v"(fq_));
          p.epi(acc, cur, ui, tab, wr, wc, fr_, fq_); }
        if (!has_next) break;
#pragma unroll
        for (int a = 0; a < 2; ++a)
#pragma unroll
            for (int b = 0; b < 2; ++b)
#pragma unroll
                for (int m = 0; m < 4; ++m)
#pragma unroll
                    for (int n = 0; n < 2; ++n) acc[a][b][m][n] = (f32x4){0.f, 0.f, 0.f, 0.f};
        cur = nxt; cA = nA; cB = nB; ++ui;
        if (wr == 1) PG8_BAR;
    }
    PG8_WAIT_V(0);
    PG8_BAR;
#undef PG8_SETA
#undef PG8_SA
#undef PG8_SB
#undef PG8_STAGE
#undef PG8_LDA
#undef PG8_LDB
#undef PG8_MMA
#undef PG8_WAIT_V
#undef PG8_WAIT_L
#undef PG8_BAR
#undef PG8_SCHED
}

struct ProbDense8 {
    static constexpr bool PERM = true, GATHER = false, GATHER_A = true; static constexpr int ESZ = 1;
    const unsigned char* A; const unsigned char* Bt; bf16_t* O; int nM, nN, ldo;
    const unsigned char* A2; const unsigned char* Bt2; bf16_t* O2; int nM2, nN2, ldo2;
    int nt, lda, ldb, G, c;
    __device__ __forceinline__ bool next(int i, Unit& u) const {
        if (c < 0) return false;
        int L = i * G + c; const int n1 = nM * nN;
        if (L < n1) { xcd_tile(L, nM, nN, u.pm, u.pn); u.e = 0; return true; }
        L -= n1; if (L >= nM2 * nN2) return false;
        xcd_tile(L, nM2, nN2, u.pm, u.pn); u.e = 1; return true;
    }
    __device__ __forceinline__ const char* a_base(const Unit& u) const { return (const char*)(u.e ? A2 : A); }
    __device__ __forceinline__ const char* b_base(const Unit& u) const { return (const char*)(u.e ? Bt2 : Bt) + (size_t)u.pn * BM * ldb; }
    __device__ __forceinline__ unsigned a_rowoff(const Unit& u, int, int r, LAS int*) const { return (unsigned)((u.pm * BM + r) * lda); }
    __device__ __forceinline__ void fill_tab(LAS int*, int, const Unit&, int) const {}
    __device__ __forceinline__ void epi(const Acc& acc, const Unit& u, int, LAS int*, int wr, int wc, int fr, int fq) const {
        bf16_t* o = u.e ? O2 : O; const int ld = u.e ? ldo2 : ldo;
        const int row0 = u.pm * BM + wr * 64 + fr, col0 = u.pn * BM + wc * 32 + 8 * fq;
        constexpr float inv = 1.0f / (8.0f * 64.0f);
#pragma unroll
        for (int ai = 0; ai < 2; ++ai)
#pragma unroll
            for (int m = 0; m < 4; ++m) { bf16_t* rowp = o + (size_t)(row0 + ai * HALF + m * 16) * ld + col0;
#pragma unroll
                for (int bj = 0; bj < 2; ++bj) { const f32x4 v0 = acc[ai][bj][m][0] * inv, v1 = acc[ai][bj][m][1] * inv;
                    u32x4 w; w.x = pk2(v0[0], v0[1]); w.y = pk2(v0[2], v0[3]); w.z = pk2(v1[0], v1[1]); w.w = pk2(v1[2], v1[3]);
                    *(u32x4*)(rowp + bj * HALF) = w; } }
    }
};
struct ProbDense {
    static constexpr bool PERM = true, GATHER = false, GATHER_A = false; static constexpr int ESZ = 2;
    const bf16_t* A; const bf16_t* Bt; bf16_t* O; int nM, nN, ldo;
    const bf16_t* A2; const bf16_t* Bt2; bf16_t* O2; int nM2, nN2, ldo2;
    int nt, lda, ldb, G, c;
    __device__ __forceinline__ bool next(int i, Unit& u) const {
        if (c < 0) return false;
        int L = i * G + c; const int n1 = nM * nN;
        if (L < n1) { xcd_tile(L, nM, nN, u.pm, u.pn); u.e = 0; return true; }
        L -= n1; if (L >= nM2 * nN2) return false;
        xcd_tile(L, nM2, nN2, u.pm, u.pn); u.e = 1; return true;
    }
    __device__ __forceinline__ const char* a_base(const Unit& u) const { return (const char*)(u.e ? A2 : A) + (size_t)u.pm * BM * lda * 2; }
    __device__ __forceinline__ const char* b_base(const Unit& u) const { return (const char*)(u.e ? Bt2 : Bt) + (size_t)u.pn * BM * ldb * 2; }
    __device__ __forceinline__ unsigned a_rowoff(const Unit&, int, int r, LAS int*) const { return (unsigned)(r * lda) * 2u; }
    __device__ __forceinline__ void fill_tab(LAS int*, int, const Unit&, int) const {}
    __device__ __forceinline__ void epi(const Acc& acc, const Unit& u, int, LAS int*, int wr, int wc, int fr, int fq) const {
        bf16_t* o = u.e ? O2 : O; const int ld = u.e ? ldo2 : ldo;
        const int row0 = u.pm * BM + wr * 64 + fr, col0 = u.pn * BM + wc * 32 + 8 * fq;
#pragma unroll
        for (int ai = 0; ai < 2; ++ai)
#pragma unroll
            for (int m = 0; m < 4; ++m) { bf16_t* rowp = o + (size_t)(row0 + ai * HALF + m * 16) * ld + col0;
#pragma unroll
                for (int bj = 0; bj < 2; ++bj) { const f32x4 v0 = acc[ai][bj][m][0], v1 = acc[ai][bj][m][1];
                    u32x4 w; w.x = pk2(v0[0], v0[1]); w.y = pk2(v0[2], v0[3]); w.z = pk2(v1[0], v1[1]); w.w = pk2(v1[2], v1[3]);
                    *(u32x4*)(rowp + bj * HALF) = w; } }
    }
};
template <bool RF32>
struct ProbOut {
    static constexpr bool PERM = true, GATHER = false, GATHER_A = false; static constexpr int ESZ = 2;
    const bf16_t* A; const bf16_t* Bt; const void* R; bf16_t* X; const float* RS; const float* Gn;
    int nt, lda, ldb, G, c;
    __device__ __forceinline__ bool next(int i, Unit& u) const { const int L = i * G + c; if (L >= 64 * 8) return false; xcd_tile(L, 64, 8, u.pm, u.pn); u.e = 0; return true; }
    __device__ __forceinline__ const char* a_base(const Unit& u) const { return (const char*)A + (size_t)u.pm * BM * lda * 2; }
    __device__ __forceinline__ const char* b_base(const Unit& u) const { return (const char*)Bt + (size_t)u.pn * BM * ldb * 2; }
    __device__ __forceinline__ unsigned a_rowoff(const Unit&, int, int r, LAS int*) const { return (unsigned)(r * lda) * 2u; }
    __device__ __forceinline__ void fill_tab(LAS int*, int, const Unit&, int) const {}
    __device__ __forceinline__ void epi(const Acc& acc, const Unit& u, int, LAS int*, int wr, int wc, int fr, int fq) const {
        const int row0 = u.pm * BM + wr * 64 + fr, col0 = u.pn * BM + wc * 32 + 8 * fq;
        f32x4 gi[2][2];
        if constexpr (RF32) {
#pragma unroll
            for (int bj = 0; bj < 2; ++bj)
#pragma unroll
                for (int q = 0; q < 2; ++q) { const f32x4 gv = *(const f32x4*)(Gn + col0 + bj * HALF + 4 * q); gi[bj][q] = (f32x4){1.0f / gv.x, 1.0f / gv.y, 1.0f / gv.z, 1.0f / gv.w}; }
        }
#pragma unroll
        for (int ai = 0; ai < 2; ++ai) {
            if constexpr (RF32) {
                u32x4 rv[4][2]; float rs[4];
#pragma unroll
                for (int m = 0; m < 4; ++m) { const bf16_t* rp = (const bf16_t*)R + (size_t)(row0 + ai * HALF + m * 16) * DM + col0; rs[m] = RS[row0 + ai * HALF + m * 16];
#pragma unroll
                    for (int bj = 0; bj < 2; ++bj) rv[m][bj] = *(const u32x4*)(rp + bj * HALF); }
                asm volatile("" ::: "memory");
#pragma unroll
                for (int m = 0; m < 4; ++m) { bf16_t* xp = X + (size_t)(row0 + ai * HALF + m * 16) * DM + col0;
#pragma unroll
                    for (int bj = 0; bj < 2; ++bj) { const u32x4 r = rv[m][bj]; const f32x4 q0 = gi[bj][0] * rs[m], q1 = gi[bj][1] * rs[m];
                        const f32x4 v0 = (f32x4){lo16(r.x), hi16(r.x), lo16(r.y), hi16(r.y)} * q0 + acc[ai][bj][m][0], v1 = (f32x4){lo16(r.z), hi16(r.z), lo16(r.w), hi16(r.w)} * q1 + acc[ai][bj][m][1];
                        u32x4 w; w.x = pk2(v0[0], v0[1]); w.y = pk2(v0[2], v0[3]); w.z = pk2(v1[0], v1[1]); w.w = pk2(v1[2], v1[3]);
                        *(u32x4*)(xp + bj * HALF) = w; } }
            } else {
                u32x4 rv[4][2];
#pragma unroll
                for (int m = 0; m < 4; ++m) { const bf16_t* rp = (const bf16_t*)R + (size_t)(row0 + ai * HALF + m * 16) * DM + col0;
#pragma unroll
                    for (int bj = 0; bj < 2; ++bj) rv[m][bj] = *(const u32x4*)(rp + bj * HALF); }
                asm volatile("" ::: "memory");
#pragma unroll
                for (int m = 0; m < 4; ++m) { bf16_t* xp = X + (size_t)(row0 + ai * HALF + m * 16) * DM + col0;
#pragma unroll
                    for (int bj = 0; bj < 2; ++bj) { const f32x4 a0 = acc[ai][bj][m][0], a1 = acc[ai][bj][m][1]; const u32x4 r = rv[m][bj];
                        u32x4 w; w.x = pk2(lo16(r.x) + a0[0], hi16(r.x) + a0[1]); w.y = pk2(lo16(r.y) + a0[2], hi16(r.y) + a0[3]);
                        w.z = pk2(lo16(r.z) + a1[0], hi16(r.z) + a1[1]); w.w = pk2(lo16(r.w) + a1[2], hi16(r.w) + a1[3]);
                        *(u32x4*)(xp + bj * HALF) = w; } }
            }
            asm volatile("" ::: "memory");
        }
    }
};
struct ProbOut8 {
    static constexpr bool PERM = true, GATHER = false, GATHER_A = true; static constexpr int ESZ = 1;
    const unsigned char* A; const unsigned char* Bt; bf16_t* X;
    int nt, lda, ldb, G, c;
    __device__ __forceinline__ bool next(int i, Unit& u) const { const int L = i * G + c; if (L >= 64 * 8) return false; xcd_tile(L, 64, 8, u.pm, u.pn); u.e = 0; return true; }
    __device__ __forceinline__ const char* a_base(const Unit&) const { return (const char*)A; }
    __device__ __forceinline__ const char* b_base(const Unit& u) const { return (const char*)Bt + (size_t)u.pn * BM * ldb; }
    __device__ __forceinline__ unsigned a_rowoff(const Unit& u, int, int r, LAS int*) const { return (unsigned)((u.pm * BM + r) * lda); }
    __device__ __forceinline__ void fill_tab(LAS int*, int, const Unit&, int) const {}
    __device__ __forceinline__ void epi(const Acc& acc, const Unit& u, int, LAS int*, int wr, int wc, int fr, int fq) const {
        const int row0 = u.pm * BM + wr * 64 + fr, col0 = u.pn * BM + wc * 32 + 8 * fq;
        constexpr float inv = 1.0f / (16.0f * 64.0f);
#pragma unroll
        for (int ai = 0; ai < 2; ++ai) {
            u32x4 rv[4][2];
#pragma unroll
            for (int m = 0; m < 4; ++m) { const bf16_t* rp = X + (size_t)(row0 + ai * HALF + m * 16) * DM + col0;
#pragma unroll
                for (int bj = 0; bj < 2; ++bj) rv[m][bj] = *(const u32x4*)(rp + bj * HALF); }
            asm volatile("" ::: "memory");
#pragma unroll
            for (int m = 0; m < 4; ++m) { bf16_t* xp = X + (size_t)(row0 + ai * HALF + m * 16) * DM + col0;
#pragma unroll
                for (int bj = 0; bj < 2; ++bj) { const f32x4 a0 = acc[ai][bj][m][0] * inv, a1 = acc[ai][bj][m][1] * inv; const u32x4 r = rv[m][bj];
                    u32x4 w; w.x = pk2(lo16(r.x) + a0[0], hi16(r.x) + a0[1]); w.y = pk2(lo16(r.y) + a0[2], hi16(r.y) + a0[3]);
                    w.z = pk2(lo16(r.z) + a1[0], hi16(r.z) + a1[1]); w.w = pk2(lo16(r.w) + a1[2], hi16(r.w) + a1[3]);
                    *(u32x4*)(xp + bj * HALF) = w; } }
            asm volatile("" ::: "memory");
        }
    }
};
struct ProbFold {
    static constexpr bool PERM = true, GATHER = false, GATHER_A = false; static constexpr int ESZ = 2;
    const bf16_t* A; const bf16_t* Bt; bf16_t* O;
    int nt, lda, ldb, G, c;
    __device__ __forceinline__ bool next(int i, Unit& u) const { if (i != 0 || c < 0 || c >= 64) return false; u.pm = c & 7; u.e = c >> 3; u.pn = 0; return true; }
    __device__ __forceinline__ const char* a_base(const Unit& u) const { return (const char*)A + ((size_t)u.pm * BM * lda + (size_t)(u.e >> 1) * 384) * 2; }
    __device__ __forceinline__ const char* b_base(const Unit& u) const { return (const char*)Bt + (size_t)u.e * BM * ldb * 2; }
    __device__ __forceinline__ unsigned a_rowoff(const Unit&, int, int r, LAS int*) const { return (unsigned)(r * lda) * 2u; }
    __device__ __forceinline__ void fill_tab(LAS int*, int, const Unit&, int) const {}
    __device__ __forceinline__ void epi(const Acc& acc, const Unit& u, int, LAS int*, int wr, int wc, int fr, int fq) const {
        const int g = u.e >> 1, hh = u.e & 1;
        const int row0 = u.pm * BM + wr * 64 + fr;
#pragma unroll
        for (int bj = 0; bj < 2; ++bj) {
            if (hh && bj) continue;
            const int col = g * 384 + hh * 256 + bj * HALF + wc * 32 + 8 * fq;
#pragma unroll
            for (int ai = 0; ai < 2; ++ai)
#pragma unroll
                for (int m = 0; m < 4; ++m) { const f32x4 v0 = acc[ai][bj][m][0], v1 = acc[ai][bj][m][1];
                    u32x4 w; w.x = pk2(v0[0], v0[1]); w.y = pk2(v0[2], v0[3]); w.z = pk2(v1[0], v1[1]); w.w = pk2(v1[2], v1[3]);
                    *(u32x4*)(O + (size_t)(row0 + ai * HALF + m * 16) * DM + col) = w; }
        }
    }
};
__device__ __forceinline__ float silu_f(float g) { return g * __builtin_amdgcn_rcpf(1.0f + __builtin_amdgcn_exp2f(-g * LOG2E)); }
constexpr float SC_X = 8.0f, SC_WGU = 64.0f, SC_H = 16.0f, SC_WDN = 32.0f;
struct ProbGU {
    static constexpr bool PERM = true, GATHER = true, GATHER_A = true; static constexpr int ESZ = 1;
    const unsigned char* A; const unsigned char* Bt; const int* IDX; bf16_t* O;
    int nt, lda, ldb, G, c;
    __device__ __forceinline__ bool next(int i, Unit& u) const { const int L = i * G + c; if (L >= 1024) return false; const int wg = (L % 8) * 128 + L / 8; u.e = wg / 64; const int w = wg % 64; u.pm = w % 8; u.pn = w / 8; return true; }
    __device__ __forceinline__ const char* a_base(const Unit&) const { return (const char*)A; }
    __device__ __forceinline__ const char* b_base(const Unit& u) const { return (const char*)Bt + (size_t)(u.e * 8 + u.pn) * BM * ldb; }
    __device__ __forceinline__ unsigned a_rowoff(const Unit&, int ui, int r, LAS int* tab) const { return (unsigned)tab[ui * 256 + r] * (unsigned)DM; }
    __device__ __forceinline__ void fill_tab(LAS int* tab, int ui, const Unit& u, int tid) const { if (tid < 256 && ui < 8) tab[ui * 256 + tid] = IDX[(u.e * 8 + u.pm) * 256 + tid]; }
    __device__ __forceinline__ void epi(const Acc& acc, const Unit& u, int, LAS int*, int wr, int wc, int fr, int fq) const {
        const int row0 = u.e * ER + u.pm * BM + wr * 64 + fr, col0 = u.pn * HALF + wc * 32 + 8 * fq;
        constexpr float inv = 1.0f / (SC_X * SC_WGU);
#pragma unroll
        for (int ai = 0; ai < 2; ++ai)
#pragma unroll
            for (int m = 0; m < 4; ++m) { const f32x4 g0 = acc[ai][0][m][0] * inv, g1 = acc[ai][0][m][1] * inv, u0 = acc[ai][1][m][0] * (inv * SC_H), u1 = acc[ai][1][m][1] * (inv * SC_H);
                u32x2 w; w.x = pk4_fp8(silu_f(g0[0]) * u0[0], silu_f(g0[1]) * u0[1], silu_f(g0[2]) * u0[2], silu_f(g0[3]) * u0[3]);
                w.y = pk4_fp8(silu_f(g1[0]) * u1[0], silu_f(g1[1]) * u1[1], silu_f(g1[2]) * u1[2], silu_f(g1[3]) * u1[3]);
                *(u32x2*)((unsigned char*)O + (size_t)(row0 + ai * HALF + m * 16) * DE + col0) = w; }
    }
};
struct ProbDN {
    static constexpr bool PERM = true, GATHER = true, GATHER_A = true; static constexpr int ESZ = 1;
    const bf16_t* A; const bf16_t* Bt; const float* GATE; bf16_t* O;
    int nt, lda, ldb, G, c;
    __device__ __forceinline__ bool next(int i, Unit& u) const { const int L = i * G + c; if (L >= 1024) return false; const int wg = (L % 8) * 128 + L / 8; u.e = wg / 64; const int w = wg % 64; u.pm = w % 8; u.pn = w / 8; return true; }
    __device__ __forceinline__ const char* a_base(const Unit&) const { return (const char*)A; }
    __device__ __forceinline__ const char* b_base(const Unit& u) const { return (const char*)Bt + (size_t)(u.e * DM + u.pn * BM) * ldb; }
    __device__ __forceinline__ unsigned a_rowoff(const Unit& u, int, int r, LAS int*) const { return (unsigned)((u.e * ER + u.pm * BM + r) * lda); }
    __device__ __forceinline__ void fill_tab(LAS int* tab, int ui, const Unit& u, int tid) const { if (tid < 256 && ui < 8) ((LAS float*)tab)[ui * 256 + tid] = GATE[(u.e * 8 + u.pm) * 256 + tid]; }
    __device__ __forceinline__ void epi(const Acc& acc, const Unit& u, int ui, LAS int* tab, int wr, int wc, int fr, int fq) const {
        const int r0 = wr * 64 + fr, pos0 = u.pn * BM + wc * 64 + 16 * fq;
        const LAS float* gp = (const LAS float*)tab + ui * 256;
#pragma unroll
        for (int ai = 0; ai < 2; ++ai)
#pragma unroll
            for (int m = 0; m < 4; ++m) { const int r = r0 + ai * HALF + m * 16; const float gt = gp[r] * (Y_SCALE / (SC_H * SC_WDN));
                const f32x4 a0 = acc[ai][0][m][0] * gt, a1 = acc[ai][0][m][1] * gt, b0 = acc[ai][1][m][0] * gt, b1 = acc[ai][1][m][1] * gt;
                u32x4 w; w.x = pk4_fp8(a0[0], a0[1], a0[2], a0[3]); w.y = pk4_fp8(a1[0], a1[1], a1[2], a1[3]); w.z = pk4_fp8(b0[0], b0[1], b0[2], b0[3]); w.w = pk4_fp8(b1[0], b1[1], b1[2], b1[3]);
                *(u32x4*)((unsigned char*)O + (size_t)(u.e * ER + u.pm * BM + r) * DM + pos0) = w; }
    }
};
}

struct Ctx {
    LAS unsigned char* lds; int tid, lane, wave, G, gw, NGW;
    int rb, rs, re;
    unsigned char* ws; gu32* ctl;
};
#define WSP(T, off) ((T*)(C.ws + (off)))

struct TItem { const float* src; bf16_t* dst; int ldw, ldt; };
__device__ __forceinline__ TItem titem(const float* W, int ldw, int k0, int n0, bf16_t* WT, int ldt, int drow0, int lane) {
    const int kg = lane >> 3, ng = lane & 7;
    TItem t; t.src = W + (size_t)(k0 + 8 * kg) * ldw + n0 + 4 * ng; t.dst = WT + (size_t)(drow0 + n0 + 4 * ng) * ldt + k0 + 8 * kg; t.ldw = ldw; t.ldt = ldt; return t;
}
__device__ __forceinline__ void titem_load(const TItem& t, f32x4 (&v)[8]) {
#pragma unroll
    for (int r = 0; r < 8; ++r) v[r] = __builtin_nontemporal_load((const f32x4*)(t.src + (size_t)r * t.ldw));
}
__device__ __forceinline__ void titem_store(const TItem& t, const f32x4 (&v)[8]) {
#pragma unroll
    for (int q = 0; q < 4; ++q) { u32x4 o; o.x = pk2(v[0][q], v[1][q]); o.y = pk2(v[2][q], v[3][q]); o.z = pk2(v[4][q], v[5][q]); o.w = pk2(v[6][q], v[7][q]);
        __builtin_nontemporal_store(o, (u32x4*)(t.dst + (size_t)q * t.ldt)); }
}
__device__ __forceinline__ void transpose_item(const float* W, int ldw, int k0, int n0, bf16_t* WT, int ldt, int drow0, LAS float*, int lane) {
    const TItem t = titem(W, ldw, k0, n0, WT, ldt, drow0, lane); f32x4 v[8]; titem_load(t, v); titem_store(t, v);
}
__device__ __forceinline__ void rms_rows_bf16(const float* X, const float* g, bf16_t* O, float* RS, int first, int stride, int nrows, int lane) {
    if (first >= nrows) return;
    f32x4 gq[4][2], xn[4][2];
#pragma unroll
    for (int j = 0; j < 4; ++j)
#pragma unroll
        for (int q = 0; q < 2; ++q) { gq[j][q] = *(const f32x4*)(g + 8 * lane + 512 * j + 4 * q); xn[j][q] = __builtin_nontemporal_load((const f32x4*)(X + (size_t)first * DM + 8 * lane + 512 * j + 4 * q)); }
    for (int m = first; m < nrows; m += stride) {
        f32x4 v[4][2]; float ss = 0.f;
#pragma unroll
        for (int j = 0; j < 4; ++j)
#pragma unroll
            for (int q = 0; q < 2; ++q) { v[j][q] = xn[j][q]; ss += (v[j][q].x * v[j][q].x + v[j][q].y * v[j][q].y) + (v[j][q].z * v[j][q].z + v[j][q].w * v[j][q].w); }
        const int mn = (m + stride < nrows) ? m + stride : m;
#pragma unroll
        for (int j = 0; j < 4; ++j)
#pragma unroll
            for (int q = 0; q < 2; ++q) xn[j][q] = __builtin_nontemporal_load((const f32x4*)(X + (size_t)mn * DM + 8 * lane + 512 * j + 4 * q));
        const float r = 1.0f / sqrtf(wave_sum(ss) * (1.0f / DM) + EPS);
        if (RS != nullptr && lane == 0) RS[m] = 1.0f / r;
#pragma unroll
        for (int j = 0; j < 4; ++j) { const f32x4 a = v[j][0] * r * gq[j][0], b = v[j][1] * r * gq[j][1];
            u32x4 o; o.x = pk2(a.x, a.y); o.y = pk2(a.z, a.w); o.z = pk2(b.x, b.y); o.w = pk2(b.z, b.w);
            *(u32x4*)(O + (size_t)m * DM + 8 * lane + 512 * j) = o; }
    }
}
constexpr int IT_LE = 1024, IT_EXP = 2 * NE * IT_LE;
constexpr int CONV1_N = 240, CONV1_ITEMS = 64 * CONV1_N;
constexpr int CONV2_WG = 96, CONV2_N = 170, SLOT2_ITEMS = CONV2_WG * CONV2_N;
constexpr int DN10_N = 0, DN10_ITEMS = CONV2_WG * DN10_N;
static_assert(NE * 512 - DN10_ITEMS <= 4 * 2048, "P11 hides one down-weight item per wave in each of its 3 window-attention units and 1 cross-attention unit");
constexpr int IT_MOVED = CONV1_ITEMS + SLOT2_ITEMS, SLOT1_ITEMS = CONV1_ITEMS;
static_assert(SLOT2_ITEMS <= IT_EXP / 2 && IT_MOVED <= IT_EXP, "P10's items are layer-1 items (needed from P15 on); P1's may be of either layer (needed from P7 on)");
struct TItem8 { const float* src; unsigned char* dst; int ldw, ldt; float sc; };
__device__ __forceinline__ TItem8 expert_titem(int r, const float* w_gate, const float* w_up, const float*, unsigned char* ws, int lane) {
    const int le = r / IT_LE, rr = r % IT_LE, kind = rr >> 9, q = rr & 511, kg = lane >> 3, ng = lane & 7;
    const int kb = q >> 5, nb = q & 31, n0 = 32 * nb, k0 = 128 * kb;
    TItem8 t;
    t.src = (kind ? w_up : w_gate) + (size_t)le * DM * DE + (size_t)(k0 + 16 * kg) * DE + n0 + 4 * ng; t.ldw = DE;
    t.dst = ws + WS_WGU + (size_t)le * DM * DM + (size_t)((n0 >> 7) * 256 + kind * 128 + (n0 & 127) + 4 * ng) * DM + k0 + 16 * kg; t.ldt = DM; t.sc = pg8::SC_WGU;
    return t;
}
__device__ __forceinline__ void titem8_load(const TItem8& t, f32x4 (&v)[16]) {
#pragma unroll
    for (int r = 0; r < 16; ++r) v[r] = __builtin_nontemporal_load((const f32x4*)(t.src + (size_t)r * t.ldw));
}
__device__ __forceinline__ void titem8_load_seq(const TItem8& t, f32x4 (&v)[16]) {
    const float* p = t.src;
#pragma unroll
    for (int r = 0; r < 16; ++r) { v[r] = __builtin_nontemporal_load((const f32x4*)p); p += t.ldw; asm volatile("" : "+v"(p)); }
}
__device__ __forceinline__ void titem8_store(const TItem8& t, const f32x4 (&v)[16]) {
#pragma unroll
    for (int q = 0; q < 4; ++q) { u32x4 o;
        o.x = pk4_fp8(v[0][q] * t.sc, v[1][q] * t.sc, v[2][q] * t.sc, v[3][q] * t.sc); o.y = pk4_fp8(v[4][q] * t.sc, v[5][q] * t.sc, v[6][q] * t.sc, v[7][q] * t.sc);
        o.z = pk4_fp8(v[8][q] * t.sc, v[9][q] * t.sc, v[10][q] * t.sc, v[11][q] * t.sc); o.w = pk4_fp8(v[12][q] * t.sc, v[13][q] * t.sc, v[14][q] * t.sc, v[15][q] * t.sc);
        __builtin_nontemporal_store(o, (u32x4*)(t.dst + (size_t)q * t.ldt)); }
}
__device__ __forceinline__ void titem8_load_half(const TItem8& t, int half, f32x4 (&v)[8]) {
    const float* p = t.src + (size_t)(8 * half) * t.ldw;
#pragma unroll
    for (int r = 0; r < 8; ++r) { v[r] = __builtin_nontemporal_load((const f32x4*)p); p += t.ldw; asm volatile("" : "+v"(p)); }
}
__device__ __forceinline__ void titem8_store_half(const TItem8& t, int half, const f32x4 (&v)[8]) {
#pragma unroll
    for (int q = 0; q < 4; ++q) { u32x2 o;
        o.x = pk4_fp8(v[0][q] * t.sc, v[1][q] * t.sc, v[2][q] * t.sc, v[3][q] * t.sc); o.y = pk4_fp8(v[4][q] * t.sc, v[5][q] * t.sc, v[6][q] * t.sc, v[7][q] * t.sc);
        __builtin_nontemporal_store(o, (u32x2*)(t.dst + (size_t)q * t.ldt + 8 * half)); }
}
__device__ __forceinline__ void expert_items(int first, int stride, int end, const float* w_gate, const float* w_up, const float* w_down, unsigned char* ws, int lane) {
    int r = first;
    for (; r + stride < end; r += 2 * stride) {
        const TItem8 t0 = expert_titem(r, w_gate, w_up, w_down, ws, lane), t1 = expert_titem(r + stride, w_gate, w_up, w_down, ws, lane);
        f32x4 v0[16], v1[16]; titem8_load(t0, v0); titem8_load(t1, v1);
        titem8_store(t0, v0); titem8_store(t1, v1);
    }
    for (; r < end; r += stride) { const TItem8 t = expert_titem(r, w_gate, w_up, w_down, ws, lane); f32x4 v[16]; titem8_load(t, v); titem8_store(t, v); }
}
__device__ __forceinline__ TItem8 down_titem(int rr, const float* w_down, unsigned char* ws, int lane) {
    const int le = rr >> 9, q = rr & 511, kb = q >> 6, nb = q & 63, kg = lane >> 3, ng = lane & 7;
    TItem8 t; t.src = w_down + (size_t)le * DE * DM + (size_t)(128 * kb + 16 * kg) * DM + 32 * nb + 4 * ng; t.ldw = DM;
    t.dst = ws + WS_WDN + (size_t)le * DM * DE + (size_t)(32 * nb + 4 * ng) * DE + 128 * kb + 16 * kg; t.ldt = DE; t.sc = pg8::SC_WDN; return t;
}
__device__ __forceinline__ void down_items(int first, int stride, int end, const float* w_down, unsigned char* ws, int lane) {
    for (int r = first; r < end; r += 2 * stride) {
        TItem8 t[2];
#pragma unroll
        for (int i = 0; i < 2; ++i) { const int rr = (r + i * stride < end) ? r + i * stride : r, le = rr >> 9, q = rr & 511, kb = q >> 6, nb = q & 63, kg = lane >> 3, ng = lane & 7;
            t[i].src = w_down + (size_t)le * DE * DM + (size_t)(128 * kb + 16 * kg) * DM + 32 * nb + 4 * ng; t[i].ldw = DM;
            t[i].dst = ws + WS_WDN + (size_t)le * DM * DE + (size_t)(32 * nb + 4 * ng) * DE + 128 * kb + 16 * kg; t[i].ldt = DE; t[i].sc = pg8::SC_WDN; }
        f32x4 v0[16], v1[16]; titem8_load(t[0], v0); titem8_load(t[1], v1); titem8_store(t[0], v0); titem8_store(t[1], v1);
    }
}
__device__ __forceinline__ void expert_slot(const Ctx& C, int first, int n, const float* w_gate, const float* w_up, const float* w_down) {
    const int base = IT_EXP - IT_MOVED + first; expert_items(base + C.wave, NWAVES, base + n, w_gate, w_up, w_down, C.ws, C.lane);
}
__device__ __forceinline__ void w8_item(const float* W, int ldw, int k0, int n0, unsigned char* WT, int lane) {
    const int kg = lane >> 3, ng = lane & 7;
    TItem8 t; t.src = W + (size_t)(k0 + 16 * kg) * ldw + n0 + 4 * ng; t.ldw = ldw; t.dst = WT + (size_t)(n0 + 4 * ng) * DM + k0 + 16 * kg; t.ldt = DM; t.sc = 64.0f;
    f32x4 v[16]; titem8_load(t, v); titem8_store(t, v);
}
__device__ __forceinline__ void p0_prologue(const Ctx& C, const float* w_gate, const float* w_up, const float* w_down, const float* w_memkv, const float* w_pin, const float* w_pout, const float* w_aout, const float* w_ain, const float* w_grp,
                                            const float* x, const float* g_mix, const float* mem, const float* g_mem, const int* pos, const float* p_scale, const float* w_router) {
    LAS float* scr = (LAS float*)(C.lds + C.wave * 8448);
    constexpr int IT_NOW = IT_EXP - IT_MOVED;
    constexpr int IT_MKV = 2 * 1024, IT_PIN = 2048, IT_SQ = 2048, IT_AIN = 16 * 76, IT_AO8 = 1024, IT_GRP = 4 * 48;
    constexpr int NITEMS = IT_NOW + IT_MKV + IT_PIN + IT_SQ + IT_AO8 + IT_AIN + IT_GRP;
    expert_items(C.gw, C.NGW, IT_NOW, w_gate, w_up, w_down, C.ws, C.lane);
    for (int it = IT_NOW + C.gw; it < NITEMS; it += C.NGW) {
        int r = it - IT_NOW;
        if (r < IT_MKV) { const int l = r >> 10, q = r & 1023; transpose_item(w_memkv + (size_t)l * DM * 1024, 1024, 64 * (q >> 5), 32 * (q & 31), WSP(bf16_t, WS_WMEMKV) + (size_t)l * 1024 * DM, DM, 0, scr, C.lane); continue; }
        r -= IT_MKV;
        if (r < IT_PIN) { transpose_item(w_pin, DM, 64 * (r >> 6), 32 * (r & 63), WSP(bf16_t, WS_WPIN), DM, 0, scr, C.lane); continue; }
        r -= IT_PIN;
        if (r < IT_AIN) { w8_item(w_ain, AIN, 128 * (r / 76), 32 * (r % 76), WSP(unsigned char, WS_WAIN), C.lane); continue; }
        r -= IT_AIN;
        if (r < IT_SQ) { transpose_item(w_pout, DM, 64 * (r >> 6), 32 * (r & 63), WSP(bf16_t, WS_WPOUT), DM, 0, scr, C.lane);
            if (64 * (r >> 6) >= TOK) transpose_item(w_pout, DM, 64 * (r >> 6), 32 * (r & 63), WSP(bf16_t, WS_WPOUT2), DM, 0, scr, C.lane);
            continue; }
        r -= IT_SQ;
        if (r < IT_AO8) { w8_item(w_aout, DM, 128 * (r >> 6), 32 * (r & 63), WSP(unsigned char, WS_WAOUT), C.lane); continue; }
        r -= IT_AO8;
        {
            const int g = r / 48, c0 = (r % 48) * 8;
            for (int idx = C.lane; idx < 8 * 96; idx += 64) { const int cr = idx / 96, d4 = (idx % 96) * 4;
                const f32x4 w = *(const f32x4*)(w_grp + ((size_t)g * 384 + c0 + cr) * 384 + d4), sc = *(const f32x4*)(p_scale + g * 384 + d4);
                u32x2 o; o.x = pk2(w.x * sc.x, w.y * sc.y); o.y = pk2(w.z * sc.z, w.w * sc.w);
                *(u32x2*)(WSP(bf16_t, WS_WGRP) + ((size_t)g * 512 + c0 + cr) * 384 + d4) = o; } }
    }
    rms_rows_bf16(x, g_mix, WSP(bf16_t, WS_XN), WSP(float, WS_RINV), C.gw, C.NGW, M, C.lane);
    rms_rows_bf16(mem, g_mem, WSP(bf16_t, WS_MEMN), nullptr, C.gw, C.NGW, MR, C.lane);
    for (int idx = blockIdx.x * NTHR + C.tid; idx < 2 * NE * DM; idx += C.G * NTHR) {
        const int layer = idx / (NE * DM), e = (idx / DM) % NE, k = idx % DM;
        const float w = w_router[((size_t)layer * DM + k) * NE + e]; const bf16_t hi = f2bf(w); const bf16_t lo = f2bf(w - bf2f(hi));
        bf16_t* o = WSP(bf16_t, WS_WRT) + (size_t)layer * 2 * NE * DM + (size_t)e * DM + k; o[0] = hi; o[NE * DM] = lo;
    }
    for (int idx = blockIdx.x * NTHR + C.tid; idx < M * 8; idx += C.G * NTHR) {
        const int m = idx >> 3, i = idx & 7;
        const float invf = i == 0 ? 1.0f : i == 1 ? 0.1939227432012558f : i == 2 ? 0.03760603070259094f : i == 3 ? 0.007292664609849453f : i == 4 ? 0.0014142135623842478f : i == 5 ? 0.00027424818836152554f : i == 6 ? 5.3182957344688475e-05f : 1.0313385246263351e-05f;
        const float ang = (float)pos[m] * invf;
        const double a = (double)ang, k = __builtin_rint(a * 0.15915494309189535), rr = a - k * 6.283185307179586;
        const float rf = (float)rr;
        WSP(float, WS_ROPE)[idx] = cosf(rf); WSP(float, WS_ROPE + 512 * 1024)[idx] = sinf(rf);
    }
}

typedef short v4i16_t __attribute__((ext_vector_type(4)));
__device__ __forceinline__ s16x4 vtr(const LAS unsigned char* p) { return __builtin_bit_cast(s16x4, __builtin_amdgcn_ds_read_tr16_b64_v4i16((LAS v4i16_t*)p)); }
template <int DH, bool WIN, bool O8, int NIT>
__device__ __forceinline__ void attn_wave(const LAS unsigned char* KL, int kstr, const LAS unsigned char* VL, int vstr, const bf16x8 (&qf)[DH / 16],
                                          int koff, int kt_lo, int kt_hi, float m_run, float l_run, float cscale, bf16_t* obase, int ldo, LAS unsigned char* stg, int lane, int ditem, int dstep, const float* w_down, unsigned char* ws) {
    const int ql = lane & 31, h = lane >> 5;
    f32x16 o[DH / 32];
#pragma unroll
    for (int b = 0; b < DH / 32; ++b)
#pragma unroll
        for (int r = 0; r < 16; ++r) o[b][r] = 0.f;
    const LAS unsigned char* vbase = VL + (4 * h + ((lane & 15) >> 2)) * vstr + (16 * ((lane >> 4) & 1) + 4 * (lane & 3)) * 2;
    f32x4 dv[8];
    { int d0 = ditem; asm volatile("" : "+s"(d0)); const TItem8 dt = down_titem(d0, w_down, ws, lane); titem8_load_half(dt, 0, dv); }
    const int kt_q = (kt_hi - kt_lo) / (2 * NIT);
    for (int kt = kt_lo; kt < kt_hi; ++kt) {
#pragma unroll
        for (int hh = 1; hh < 2 * NIT; ++hh)
            if (kt == kt_lo + hh * kt_q) { int d1 = ditem + ((hh - 1) >> 1) * dstep, d2 = ditem + (hh >> 1) * dstep; asm volatile("" : "+s"(d1), "+s"(d2));
                const TItem8 dta = down_titem(d1, w_down, ws, lane), dtb = down_titem(d2, w_down, ws, lane); titem8_store_half(dta, (hh - 1) & 1, dv); titem8_load_half(dtb, hh & 1, dv); }
        f32x16 s;
#pragma unroll
        for (int r = 0; r < 16; ++r) s[r] = 0.f;
        const LAS unsigned char* kp = KL + ((kt + koff) * 32 + ql) * kstr + h * 16;
#pragma unroll
        for (int st = 0; st < DH / 16; ++st) { const bf16x8 kf = *(const LAS bf16x8*)(kp + st * 32); s = __builtin_amdgcn_mfma_f32_32x32x16_bf16(kf, qf[st], s, 0, 0, 0); }
        if (WIN) {
            if (kt == 0) {
#pragma unroll
                for (int r = 0; r < 16; ++r) if (crow(r, h) < ql) s[r] = -1e30f;
            }
            if (kt == 8) {
#pragma unroll
                for (int r = 0; r < 16; ++r) if (crow(r, h) > ql) s[r] = -1e30f;
            }
        }
        float mx = s[0];
#pragma unroll
        for (int r = 1; r < 16; ++r) mx = fmaxf(mx, s[r]);
        mx = fmaxf(mx, __shfl_xor(mx, 32));
        const float mxs = mx * cscale;
        if (__any(mxs > m_run + 8.0f)) {
            const float m_new = fmaxf(m_run, mxs), alpha = __builtin_amdgcn_exp2f(m_run - m_new);
            m_run = m_new; l_run *= alpha;
#pragma unroll
            for (int b = 0; b < DH / 32; ++b)
#pragma unroll
                for (int r = 0; r < 16; ++r) o[b][r] *= alpha;
        }
        const float nm = -m_run; float ps = 0.f;
#pragma unroll
        for (int r = 0; r < 16; ++r) { s[r] = __builtin_amdgcn_exp2f(__builtin_fmaf(s[r], cscale, nm)); ps += s[r]; }
        l_run += ps;
        bf16x8 pf[2];
#pragma unroll
        for (int s2 = 0; s2 < 2; ++s2) { u32x4 w; w.x = pk2(s[8 * s2 + 0], s[8 * s2 + 1]); w.y = pk2(s[8 * s2 + 2], s[8 * s2 + 3]); w.z = pk2(s[8 * s2 + 4], s[8 * s2 + 5]); w.w = pk2(s[8 * s2 + 6], s[8 * s2 + 7]); pf[s2] = __builtin_bit_cast(bf16x8, w); }
        const LAS unsigned char* vp = vbase + ((kt + koff) * 32) * vstr;
#pragma unroll
        for (int b = 0; b < DH / 32; ++b) {
#pragma unroll
            for (int s2 = 0; s2 < 2; ++s2) {
                const s16x4 lo = vtr(vp + (16 * s2) * vstr + b * 64), hi = vtr(vp + (16 * s2 + 8) * vstr + b * 64);
                const bf16x8 vf = (bf16x8){lo[0], lo[1], lo[2], lo[3], hi[0], hi[1], hi[2], hi[3]};
                o[b] = __builtin_amdgcn_mfma_f32_32x32x16_bf16(vf, pf[s2], o[b], 0, 0, 0);
            }
        }
    }
    { int d2 = ditem + (NIT - 1) * dstep; asm volatile("" : "+s"(d2)); const TItem8 dt = down_titem(d2, w_down, ws, lane); titem8_store_half(dt, 1, dv); }
    const float lt = l_run + __shfl_xor(l_run, 32), rl = 1.0f / lt;
    __syncthreads();
    if constexpr (O8) {
        constexpr int SST = DH + 16; const float rs = rl * SC_CAT;
#pragma unroll
        for (int b = 0; b < DH / 32; ++b)
#pragma unroll
            for (int rg = 0; rg < 4; ++rg) *(LAS unsigned*)(stg + ql * SST + (b * 32 + 8 * rg + 4 * h)) = pk4_fp8(o[b][4 * rg] * rs, o[b][4 * rg + 1] * rs, o[b][4 * rg + 2] * rs, o[b][4 * rg + 3] * rs);
        constexpr int CPR = DH / 16, RPI = 64 / CPR;
#pragma unroll
        for (int i = 0; i < 32 / RPI; ++i) { const int row = i * RPI + lane / CPR, ch = lane % CPR;
            const u32x4 v = *(const LAS u32x4*)(stg + row * SST + ch * 16);
            *(u32x4*)((unsigned char*)obase + (size_t)row * ldo + ch * 16) = v; }
    } else {
    constexpr int SST = DH * 2 + 16;
#pragma unroll
    for (int b = 0; b < DH / 32; ++b)
#pragma unroll
        for (int rg = 0; rg < 4; ++rg) { u32x2 w; w.x = pk2(o[b][4 * rg] * rl, o[b][4 * rg + 1] * rl); w.y = pk2(o[b][4 * rg + 2] * rl, o[b][4 * rg + 3] * rl);
            *(LAS u32x2*)(stg + ql * SST + (b * 32 + 8 * rg + 4 * h) * 2) = w; }
    constexpr int CPR = DH / 8, RPI = 64 / CPR;
#pragma unroll
    for (int i = 0; i < 32 / RPI; ++i) { const int row = i * RPI + lane / CPR, ch = lane % CPR;
        const u32x4 v = *(const LAS u32x4*)(stg + row * SST + ch * 16);
        *(u32x4*)(obase + (size_t)row * ldo + ch * 8) = v; }
    }
}

__device__ __forceinline__ void attn_win2(const LAS unsigned char* KL, int kstr, const LAS unsigned char* VL, int vstr, const bf16x8 (&qfA)[4], const bf16x8 (&qfB)[4],
                                          int j_lo, int j_hi, float m0, float cscale, unsigned char* obaseA, unsigned char* obaseB, int ldo, LAS unsigned char* stg, int lane, int ditem, const float* w_down, unsigned char* ws) {
    const int ql = lane & 31, h = lane >> 5;
    f32x16 oA[2], oB[2];
#pragma unroll
    for (int b = 0; b < 2; ++b)
#pragma unroll
        for (int r = 0; r < 16; ++r) { oA[b][r] = 0.f; oB[b][r] = 0.f; }
    float mA = m0, mB = m0, lA = h ? 0.f : 1.f, lB = h ? 0.f : 1.f;
    const LAS unsigned char* vbase = VL + (4 * h + ((lane & 15) >> 2)) * vstr + (16 * ((lane >> 4) & 1) + 4 * (lane & 3)) * 2;
#define WA_QK(S, QF) do { _Pragma("unroll") for (int r = 0; r < 16; ++r) S[r] = 0.f; \
        _Pragma("unroll") for (int st = 0; st < 4; ++st) { const bf16x8 kf_ = *(const LAS bf16x8*)(kp + st * 32); S = __builtin_amdgcn_mfma_f32_32x32x16_bf16(kf_, QF[st], S, 0, 0, 0); } } while (0)
#define WA_QK2(SA, SB) do { _Pragma("unroll") for (int r = 0; r < 16; ++r) { SA[r] = 0.f; SB[r] = 0.f; } \
        _Pragma("unroll") for (int st = 0; st < 4; ++st) { const bf16x8 kf_ = *(const LAS bf16x8*)(kp + st * 32); SA = __builtin_amdgcn_mfma_f32_32x32x16_bf16(kf_, qfA[st], SA, 0, 0, 0); SB = __builtin_amdgcn_mfma_f32_32x32x16_bf16(kf_, qfB[st], SB, 0, 0, 0); } } while (0)
#define WA_MASK_LO(S) do { _Pragma("unroll") for (int r = 0; r < 16; ++r) if (crow(r, h) < ql) S[r] = -1e30f; } while (0)
#define WA_MASK_HI(S) do { _Pragma("unroll") for (int r = 0; r < 16; ++r) if (crow(r, h) > ql) S[r] = -1e30f; } while (0)
#define WA_SMPV(S, O, MR, LR) do { float mx_ = S[0]; _Pragma("unroll") for (int r = 1; r < 16; ++r) mx_ = fmaxf(mx_, S[r]); \
        mx_ = fmaxf(mx_, __shfl_xor(mx_, 32)); const float mxs_ = mx_ * cscale; \
        if (__any(mxs_ > MR + 8.0f)) { const float mn_ = fmaxf(MR, mxs_), al_ = __builtin_amdgcn_exp2f(MR - mn_); MR = mn_; LR *= al_; \
            _Pragma("unroll") for (int b = 0; b < 2; ++b) _Pragma("unroll") for (int r = 0; r < 16; ++r) O[b][r] *= al_; } \
        const float nm_ = -MR; float ps_ = 0.f; \
        _Pragma("unroll") for (int r = 0; r < 16; ++r) { S[r] = __builtin_amdgcn_exp2f(__builtin_fmaf(S[r], cscale, nm_)); ps_ += S[r]; } \
        LR += ps_; \
        _Pragma("unroll") for (int s2 = 0; s2 < 2; ++s2) { u32x4 w_; w_.x = pk2(S[8 * s2 + 0], S[8 * s2 + 1]); w_.y = pk2(S[8 * s2 + 2], S[8 * s2 + 3]); w_.z = pk2(S[8 * s2 + 4], S[8 * s2 + 5]); w_.w = pk2(S[8 * s2 + 6], S[8 * s2 + 7]); \
            const bf16x8 pf_ = __builtin_bit_cast(bf16x8, w_); \
            _Pragma("unroll") for (int b = 0; b < 2; ++b) { const s16x4 lo_ = vtr(vp + (16 * s2) * vstr + b * 64), hi_ = vtr(vp + (16 * s2 + 8) * vstr + b * 64); \
                const bf16x8 vf_ = (bf16x8){lo_[0], lo_[1], lo_[2], lo_[3], hi_[0], hi_[1], hi_[2], hi_[3]}; O[b] = __builtin_amdgcn_mfma_f32_32x32x16_bf16(vf_, pf_, O[b], 0, 0, 0); } } } while (0)
    f32x4 dv[8];
    { int d0 = ditem; asm volatile("" : "+s"(d0)); const TItem8 dt = down_titem(d0, w_down, ws, lane); titem8_load_half(dt, 0, dv); }
    for (int j = j_lo; j < j_hi; ++j) {
        if (j == 5) { int d1 = ditem; asm volatile("" : "+s"(d1)); const TItem8 dt = down_titem(d1, w_down, ws, lane); titem8_store_half(dt, 0, dv); titem8_load_half(dt, 1, dv); }
        const LAS unsigned char* kp = KL + (j * 32 + ql) * kstr + h * 16;
        const LAS unsigned char* vp = vbase + (j * 32) * vstr;
        f32x16 sA, sB;
        if (j >= 2 && j <= 7) {
            WA_QK2(sA, sB);
            WA_SMPV(sA, oA, mA, lA); WA_SMPV(sB, oB, mB, lB);
        } else {
            if (j <= 8) { WA_QK(sA, qfA); if (j == 0) WA_MASK_LO(sA); if (j == 8) WA_MASK_HI(sA); WA_SMPV(sA, oA, mA, lA); }
            if (j >= 1) { WA_QK(sB, qfB); if (j == 1) WA_MASK_LO(sB); if (j == 9) WA_MASK_HI(sB); WA_SMPV(sB, oB, mB, lB); }
        }
    }
    { int d2 = ditem; asm volatile("" : "+s"(d2)); const TItem8 dt = down_titem(d2, w_down, ws, lane); titem8_store_half(dt, 1, dv); }
#undef WA_QK
#undef WA_QK2
#undef WA_MASK_LO
#undef WA_MASK_HI
#undef WA_SMPV
    const float rlA = 1.0f / (lA + __shfl_xor(lA, 32)), rlB = 1.0f / (lB + __shfl_xor(lB, 32));
    const float rsA = rlA * SC_CAT, rsB = rlB * SC_CAT;
#pragma unroll
    for (int t2 = 0; t2 < 2; ++t2) {
#pragma unroll
        for (int b = 0; b < 2; ++b)
#pragma unroll
            for (int rg = 0; rg < 4; ++rg) { unsigned w;
                if (t2 == 0) w = pk4_fp8(oA[b][4 * rg] * rsA, oA[b][4 * rg + 1] * rsA, oA[b][4 * rg + 2] * rsA, oA[b][4 * rg + 3] * rsA);
                else         w = pk4_fp8(oB[b][4 * rg] * rsB, oB[b][4 * rg + 1] * rsB, oB[b][4 * rg + 2] * rsB, oB[b][4 * rg + 3] * rsB);
                *(LAS unsigned*)(stg + ql * 80 + (b * 32 + 8 * rg + 4 * h)) = w; }
        unsigned char* ob = t2 ? obaseB : obaseA;
#pragma unroll
        for (int i = 0; i < 2; ++i) { const int row = i * 16 + (lane >> 2), ch = lane & 3;
            const u32x4 v = *(const LAS u32x4*)(stg + row * 80 + ch * 16);
            *(u32x4*)(ob + (size_t)row * ldo + ch * 16) = v; }
    }
}

template <bool O8, int NIT>
__device__ __forceinline__ void xattn_unit(const Ctx& C, int u, const bf16_t* PROJ, int ldp, int qcol0, int kvcol0, int ditem, int dstep, const float* w_down) {
    constexpr int KSTR = 272, VSTR = 288;
    LAS unsigned char* KL = C.lds; LAS unsigned char* VL = C.lds + 256 * KSTR;
    const int b = u >> 5, head = (u >> 3) & 3, qt = u & 7;
    const bf16_t* KV = WSP(bf16_t, WS_MEMKV) + (size_t)(b * MEML) * DM + kvcol0 + head * 128;
    const int row = b * SEQ + qt * 256 + C.wave * 32 + (C.lane & 31), h = C.lane >> 5;
    bf16x8 qf[8];
#pragma unroll
    for (int st = 0; st < 8; ++st) qf[st] = *(const bf16x8*)(PROJ + (size_t)row * ldp + qcol0 + head * 128 + st * 16 + h * 8);
    __syncthreads();
    {
        u32x4 kv[8], vv[8];
#pragma unroll
        for (int k = 0; k < 8; ++k) { const int it = C.tid + k * NTHR, i = it >> 4, c = it & 15;
            kv[k] = *(const u32x4*)(KV + (size_t)i * DM + c * 8); vv[k] = *(const u32x4*)(KV + (size_t)i * DM + 512 + c * 8); }
#pragma unroll
        for (int k = 0; k < 8; ++k) { const int it = C.tid + k * NTHR, i = it >> 4, c = it & 15;
            *(LAS u32x4*)(KL + i * KSTR + c * 16) = kv[k]; *(LAS u32x4*)(VL + i * VSTR + c * 16) = vv[k]; }
    }
    LDS_WAIT(); __syncthreads();
    bf16_t* ob = O8 ? (bf16_t*)(WSP(unsigned char, WS_CAT) + (size_t)(b * SEQ + qt * 256 + C.wave * 32) * DM + TOK + head * 128) : WSP(bf16_t, WS_CAT) + (size_t)(b * SEQ + qt * 256 + C.wave * 32) * DM + TOK + head * 128;
    attn_wave<128, false, O8, NIT>(KL, KSTR, VL, VSTR, qf, 0, 0, 8, -1e30f, 0.f, 0.08838834764831845f * LOG2E, ob, DM, KL + C.wave * (32 * 272), C.lane, ditem, dstep, w_down, C.ws);
}
__device__ __forceinline__ void wattn_unit(const Ctx& C0, int u, const float* sinkp, int ditem, const float* w_down) {
    Ctx C = C0; asm volatile("" : "+v"(C.tid), "+v"(C.lane));
    constexpr int KSTR = 144, VSTR = 192, NK = 320;
    LAS unsigned char* KL = C.lds; LAS unsigned char* VL = C.lds + NK * KSTR;
    const int b = u / 96, kvh = (u / 32) % 3, qt = u % 32, q0u = qt * 64, kbase = q0u - 128;
    const bf16_t* P = WSP(bf16_t, WS_PROJ);
    const float* RC = WSP(float, WS_ROPE); const float* RS = WSP(float, WS_ROPE + 512 * 1024);
    const int head = kvh * 8 + C.wave, h = C.lane >> 5;
    const float sk = sinkp[head] * LOG2E;
    bf16x8 qf[2][4]; f32x4 qc0[2], qc1[2], qs0[2], qs1[2];
#pragma unroll
    for (int t2 = 0; t2 < 2; ++t2) {
        const size_t row = (size_t)(b * SEQ + q0u + t2 * 32 + (C.lane & 31));
#pragma unroll
        for (int st = 0; st < 4; ++st) qf[t2][st] = *(const bf16x8*)(P + row * AINP + head * 64 + st * 16 + h * 8);
        qc0[t2] = *(const f32x4*)(RC + row * 8); qc1[t2] = *(const f32x4*)(RC + row * 8 + 4); qs0[t2] = *(const f32x4*)(RS + row * 8); qs1[t2] = *(const f32x4*)(RS + row * 8 + 4);
    }

    __syncthreads();
    {
        u32x4 kv[4], vv[5];
#pragma unroll
        for (int k = 0; k < 4; ++k) { const int it = C.tid + k * NTHR, i = it / 6, c = 2 + it % 6, kpos = kbase + i;
            kv[k] = (it < NK * 6 && kpos >= 0 && kpos < SEQ) ? *(const u32x4*)(P + (size_t)(b * SEQ + kpos) * AINP + TOK + kvh * 64 + c * 8) : (u32x4){0u, 0u, 0u, 0u}; }
#pragma unroll
        for (int k = 0; k < 5; ++k) { const int it = C.tid + k * NTHR, i = it >> 3, c = it & 7, kpos = kbase + i;
            vv[k] = (kpos >= 0 && kpos < SEQ) ? *(const u32x4*)(P + (size_t)(b * SEQ + kpos) * AINP + TOK + KVW + kvh * 64 + c * 8) : (u32x4){0u, 0u, 0u, 0u}; }
        if (C.tid < NK) {
            const int i = C.tid, kpos = kbase + i;
            if (kpos >= 0 && kpos < SEQ) {
                const size_t rowi = (size_t)(b * SEQ + kpos);
                const bf16_t* kr = P + rowi * AINP + TOK + kvh * 64;
                const u32x4 k1 = *(const u32x4*)kr, k2 = *(const u32x4*)(kr + 8);
                const f32x4 c0 = *(const f32x4*)(RC + rowi * 8), c1 = *(const f32x4*)(RC + rowi * 8 + 4), s0 = *(const f32x4*)(RS + rowi * 8), s1 = *(const f32x4*)(RS + rowi * 8 + 4);
                u32x4 n1, n2;
                n1.x = pk2(lo16(k1.x) * c0.x - lo16(k2.x) * s0.x, hi16(k1.x) * c0.y - hi16(k2.x) * s0.y); n2.x = pk2(lo16(k2.x) * c0.x + lo16(k1.x) * s0.x, hi16(k2.x) * c0.y + hi16(k1.x) * s0.y);
                n1.y = pk2(lo16(k1.y) * c0.z - lo16(k2.y) * s0.z, hi16(k1.y) * c0.w - hi16(k2.y) * s0.w); n2.y = pk2(lo16(k2.y) * c0.z + lo16(k1.y) * s0.z, hi16(k2.y) * c0.w + hi16(k1.y) * s0.w);
                n1.z = pk2(lo16(k1.z) * c1.x - lo16(k2.z) * s1.x, hi16(k1.z) * c1.y - hi16(k2.z) * s1.y); n2.z = pk2(lo16(k2.z) * c1.x + lo16(k1.z) * s1.x, hi16(k2.z) * c1.y + hi16(k1.z) * s1.y);
                n1.w = pk2(lo16(k1.w) * c1.z - lo16(k2.w) * s1.z, hi16(k1.w) * c1.w - hi16(k2.w) * s1.w); n2.w = pk2(lo16(k2.w) * c1.z + lo16(k1.w) * s1.z, hi16(k2.w) * c1.w + hi16(k1.w) * s1.w);
                *(LAS u32x4*)(KL + i * KSTR) = n1; *(LAS u32x4*)(KL + i * KSTR + 16) = n2;
            }
        }
#pragma unroll
        for (int k = 0; k < 4; ++k) { const int it = C.tid + k * NTHR, i = it / 6, c = 2 + it % 6; if (it < NK * 6) *(LAS u32x4*)(KL + i * KSTR + c * 16) = kv[k]; }
#pragma unroll
        for (int k = 0; k < 5; ++k) { const int it = C.tid + k * NTHR, i = it >> 3, c = it & 7; *(LAS u32x4*)(VL + i * VSTR + c * 16) = vv[k]; }
    }
#pragma unroll
    for (int t2 = 0; t2 < 2; ++t2) {
        const u32x4 mine = __builtin_bit_cast(u32x4, qf[t2][0]);
        u32x4 oth; oth.x = __shfl_xor(mine.x, 32); oth.y = __shfl_xor(mine.y, 32); oth.z = __shfl_xor(mine.z, 32); oth.w = __shfl_xor(mine.w, 32);
        const f32x4 c0 = qc0[t2], c1 = qc1[t2], s0 = qs0[t2], s1 = qs1[t2];
        const float sg = h ? 1.f : -1.f;
        u32x4 nv;
        nv.x = pk2(lo16(mine.x) * c0.x + sg * lo16(oth.x) * s0.x, hi16(mine.x) * c0.y + sg * hi16(oth.x) * s0.y);
        nv.y = pk2(lo16(mine.y) * c0.z + sg * lo16(oth.y) * s0.z, hi16(mine.y) * c0.w + sg * hi16(oth.y) * s0.w);
        nv.z = pk2(lo16(mine.z) * c1.x + sg * lo16(oth.z) * s1.x, hi16(mine.z) * c1.y + sg * hi16(oth.z) * s1.y);
        nv.w = pk2(lo16(mine.w) * c1.z + sg * lo16(oth.w) * s1.z, hi16(mine.w) * c1.w + sg * hi16(oth.w) * s1.w);
        qf[t2][0] = __builtin_bit_cast(bf16x8, nv);
    }
    LDS_WAIT(); __syncthreads();
    {
        const size_t rowA = (size_t)(b * SEQ + q0u + (C.lane & 31));
        const int j_lo = q0u >= 128 ? 0 : (128 - q0u) / 32;
        int j_hi = (SEQ + 128 - q0u) / 32; if (j_hi > 10) j_hi = 10;
        const size_t row0 = (size_t)(b * SEQ + q0u);
        attn_win2(KL, KSTR, VL, VSTR, qf[0], qf[1], j_lo, j_hi, sk, 0.125f * LOG2E, WSP(unsigned char, WS_CAT) + row0 * DM + head * 64, WSP(unsigned char, WS_CAT) + (row0 + 32) * DM + head * 64, DM, VL + NK * VSTR + C.wave * (32 * 144), C.lane, ditem, w_down, C.ws);
    }
}

template <int HW>
__device__ __forceinline__ void pool_item4(const bf16_t* P, bf16_t* O, int m0, int c) {
    const int t0 = m0 & (SEQ - 1);
    const bf16_t* base = P + (size_t)(m0 - t0) * DM + c * 8;
    constexpr int NR = 2 * HW + 3;
    u32x4 v[NR];
#pragma unroll
    for (int jj = 0; jj < NR; ++jj) { int j = t0 - HW + jj; j = j < 0 ? 0 : (j > SEQ - 1 ? SEQ - 1 : j); v[jj] = *(const u32x4*)(base + (size_t)j * DM); }
    float a[8];
#pragma unroll
    for (int k = 0; k < 8; ++k) a[k] = 0.f;
#pragma unroll
    for (int jj = 0; jj < 2 * HW; ++jj) { const int j = t0 - HW + jj; const float wv = (j >= 0 && j < SEQ) ? 1.f : 0.f;
        a[0] += wv * lo16(v[jj].x); a[1] += wv * hi16(v[jj].x); a[2] += wv * lo16(v[jj].y); a[3] += wv * hi16(v[jj].y);
        a[4] += wv * lo16(v[jj].z); a[5] += wv * hi16(v[jj].z); a[6] += wv * lo16(v[jj].w); a[7] += wv * hi16(v[jj].w); }
#pragma unroll
    for (int i = 0; i < 4; ++i) {
        const int t = t0 + i;
        if (i > 0) {
            const int jo = t - 1 - HW, jn = t + HW - 1; const float wo = (jo >= 0) ? 1.f : 0.f, wn = (jn < SEQ) ? 1.f : 0.f;
            const u32x4 vo = v[i - 1], vn = v[2 * HW + i - 1];
            a[0] += wn * lo16(vn.x) - wo * lo16(vo.x); a[1] += wn * hi16(vn.x) - wo * hi16(vo.x); a[2] += wn * lo16(vn.y) - wo * lo16(vo.y); a[3] += wn * hi16(vn.y) - wo * hi16(vo.y);
            a[4] += wn * lo16(vn.z) - wo * lo16(vo.z); a[5] += wn * hi16(vn.z) - wo * hi16(vo.z); a[6] += wn * lo16(vn.w) - wo * lo16(vo.w); a[7] += wn * hi16(vn.w) - wo * hi16(vo.w);
        }
        int lo = t - HW; if (lo < 0) lo = 0; int hi = t + HW - 1; if (hi > SEQ - 1) hi = SEQ - 1;
        const float rc = 1.0f / (float)(hi - lo + 1);
        const u32x4 sv = v[HW + i];
        u32x4 o; o.x = pk2(a[0] * rc - lo16(sv.x), a[1] * rc - hi16(sv.x)); o.y = pk2(a[2] * rc - lo16(sv.y), a[3] * rc - hi16(sv.y));
        o.z = pk2(a[4] * rc - lo16(sv.z), a[5] * rc - hi16(sv.z)); o.w = pk2(a[6] * rc - lo16(sv.w), a[7] * rc - hi16(sv.w));
        *(u32x4*)(O + (size_t)(m0 + i) * DM + c * 8) = o;
    }
}
__device__ __forceinline__ void pool_phase(const Ctx& C) {
    const bf16_t* P = WSP(bf16_t, WS_PROJ); bf16_t* O = WSP(bf16_t, WS_CAT);
    if (C.lane >= 48) return;
    for (int wi = C.rb; wi < C.re; wi += C.rs) {
        const int g = wi & 3, m0 = 4 * (wi >> 2), c = g * 48 + C.lane;
        if (g == 0) pool_item4<1>(P, O, m0, c); else if (g == 1) pool_item4<2>(P, O, m0, c); else if (g == 2) pool_item4<4>(P, O, m0, c); else pool_item4<8>(P, O, m0, c);
    }
}

__device__ __forceinline__ void router_phase(const Ctx& C, const bf16_t* X, const float* g, const float* Wr) {
    LAS float* WL = (LAS float*)C.lds;
    __syncthreads();
    for (int idx = C.tid; idx < DM * NE / 4; idx += NTHR) { const f32x4 w = *(const f32x4*)(Wr + (size_t)idx * 4); const int k = idx >> 2, e0 = (idx & 3) * 4;
        WL[(e0 + 0) * DM + k] = w.x; WL[(e0 + 1) * DM + k] = w.y; WL[(e0 + 2) * DM + k] = w.z; WL[(e0 + 3) * DM + k] = w.w; }
    LDS_WAIT(); __syncthreads();
    unsigned char* XN8 = WSP(unsigned char, WS_XN8); float* AFFT = WSP(float, WS_AFFT);
    u32x2 xa[8], xb[8]; f32x4 gq[8];
#pragma unroll
    for (int jj = 0; jj < 8; ++jj) gq[jj] = *(const f32x4*)(g + 4 * C.lane + 256 * jj);
    if (C.gw < M) {
        const int mb = (C.gw + C.NGW < M) ? C.gw + C.NGW : C.gw;
#pragma unroll
        for (int jj = 0; jj < 8; ++jj) { xa[jj] = *(const u32x2*)(X + (size_t)C.gw * DM + 4 * C.lane + 256 * jj); xb[jj] = *(const u32x2*)(X + (size_t)mb * DM + 4 * C.lane + 256 * jj); }
    }
    for (int m0 = C.gw; m0 < M; m0 += 2 * C.NGW) {
        const bool two = m0 + C.NGW < M; const int m1 = two ? m0 + C.NGW : m0;
        u32x2 ca[8], cb[8]; float ssa = 0.f, ssb = 0.f;
#pragma unroll
        for (int jj = 0; jj < 8; ++jj) { ca[jj] = xa[jj]; cb[jj] = xb[jj];
            const float a0 = lo16(ca[jj].x), a1 = hi16(ca[jj].x), a2 = lo16(ca[jj].y), a3 = hi16(ca[jj].y), b0 = lo16(cb[jj].x), b1 = hi16(cb[jj].x), b2_ = lo16(cb[jj].y), b3_ = hi16(cb[jj].y);
            ssa += (a0 * a0 + a1 * a1) + (a2 * a2 + a3 * a3); ssb += (b0 * b0 + b1 * b1) + (b2_ * b2_ + b3_ * b3_); }
        { const int na = (m0 + 2 * C.NGW < M) ? m0 + 2 * C.NGW : m0, nb = (m0 + 3 * C.NGW < M) ? m0 + 3 * C.NGW : na;
#pragma unroll
          for (int jj = 0; jj < 8; ++jj) { xa[jj] = *(const u32x2*)(X + (size_t)na * DM + 4 * C.lane + 256 * jj); xb[jj] = *(const u32x2*)(X + (size_t)nb * DM + 4 * C.lane + 256 * jj); } }
        const float ra = 1.0f / sqrtf(wave_sum(ssa) * (1.0f / DM) + EPS), rb = 1.0f / sqrtf(wave_sum(ssb) * (1.0f / DM) + EPS);
        f32x2 lab[NE];
#pragma unroll
        for (int e = 0; e < NE; ++e) lab[e] = (f32x2){0.f, 0.f};
#pragma unroll
        for (int jj = 0; jj < 8; ++jj) {
            const f32x4 a = (f32x4){lo16(ca[jj].x), hi16(ca[jj].x), lo16(ca[jj].y), hi16(ca[jj].y)} * ra * gq[jj], b = (f32x4){lo16(cb[jj].x), hi16(cb[jj].x), lo16(cb[jj].y), hi16(cb[jj].y)} * rb * gq[jj];
            *(unsigned*)(XN8 + (size_t)m0 * DM + 4 * C.lane + 256 * jj) = pk4_fp8(a.x * pg8::SC_X, a.y * pg8::SC_X, a.z * pg8::SC_X, a.w * pg8::SC_X);
            *(unsigned*)(XN8 + (size_t)m1 * DM + 4 * C.lane + 256 * jj) = pk4_fp8(b.x * pg8::SC_X, b.y * pg8::SC_X, b.z * pg8::SC_X, b.w * pg8::SC_X);
            const f32x2 p0 = {a.x, b.x}, p1 = {a.y, b.y}, p2 = {a.z, b.z}, p3 = {a.w, b.w};
#pragma unroll
            for (int e = 0; e < NE; ++e) { const f32x4 w = *(const LAS f32x4*)(WL + e * DM + 256 * jj + 4 * C.lane);
                lab[e] = __builtin_elementwise_fma(p0, (f32x2){w.x, w.x}, lab[e]); lab[e] = __builtin_elementwise_fma(p1, (f32x2){w.y, w.y}, lab[e]);
                lab[e] = __builtin_elementwise_fma(p2, (f32x2){w.z, w.z}, lab[e]); lab[e] = __builtin_elementwise_fma(p3, (f32x2){w.w, w.w}, lab[e]);
                if ((e & 7) == 7) asm volatile("" : "+v"(lab[e]) :: "memory"); }
        }
        const bool b5 = C.lane & 32, b4 = C.lane & 16, b3 = C.lane & 8, b2 = C.lane & 4;
        const int eidx = ((C.lane >> 5) & 1) * 8 + ((C.lane >> 4) & 1) * 4 + ((C.lane >> 3) & 1) * 2 + ((C.lane >> 2) & 1);
#pragma unroll
        for (int rr = 0; rr < 2; ++rr) {
            float v8[8], v4[4], v2[2];
#pragma unroll
            for (int i = 0; i < 8; ++i) { const float lo = rr ? lab[i].y : lab[i].x, hi = rr ? lab[8 + i].y : lab[8 + i].x; v8[i] = (b5 ? hi : lo) + __shfl_xor(b5 ? lo : hi, 32); }
#pragma unroll
            for (int i = 0; i < 4; ++i) v4[i] = (b4 ? v8[4 + i] : v8[i]) + __shfl_xor(b4 ? v8[i] : v8[4 + i], 16);
#pragma unroll
            for (int i = 0; i < 2; ++i) v2[i] = (b3 ? v4[2 + i] : v4[i]) + __shfl_xor(b3 ? v4[i] : v4[2 + i], 8);
            float lgt = (b2 ? v2[1] : v2[0]) + __shfl_xor(b2 ? v2[0] : v2[1], 4);
            lgt += __shfl_xor(lgt, 2); lgt += __shfl_xor(lgt, 1);
            float mx = lgt;
            mx = fmaxf(mx, __shfl_xor(mx, 32)); mx = fmaxf(mx, __shfl_xor(mx, 16)); mx = fmaxf(mx, __shfl_xor(mx, 8)); mx = fmaxf(mx, __shfl_xor(mx, 4));
            const float ex = __expf(lgt - mx);
            float se = ex;
            se += __shfl_xor(se, 32); se += __shfl_xor(se, 16); se += __shfl_xor(se, 8); se += __shfl_xor(se, 4);
            const int m = rr ? m1 : m0;
            if ((C.lane & 3) == 0 && (rr == 0 || two)) AFFT[((size_t)(m >> 11) * NE + eidx) * SEQ + (m & (SEQ - 1))] = ex / se;
        }
    }
}

__device__ __forceinline__ void router_phase_mfma(const Ctx& C, const bf16_t* X, const float* g, const bf16_t* WRT) {
    constexpr int RS = 4112;
    LAS unsigned char* T = C.lds; LAS float* PART = (LAS float*)(C.lds + 32 * RS);
    unsigned char* XN8 = WSP(unsigned char, WS_XN8); float* AFFT = WSP(float, WS_AFFT);
    const int l15 = C.lane & 15, kq = C.lane >> 4;
    bf16x8 bhi[8], blo[8];
#pragma unroll
    for (int s2 = 0; s2 < 8; ++s2) { const bf16_t* wp = WRT + (size_t)l15 * DM + 256 * C.wave + 32 * s2 + 8 * kq; bhi[s2] = *(const bf16x8*)wp; blo[s2] = *(const bf16x8*)(wp + NE * DM); }
    f32x4 gq[8];
#pragma unroll
    for (int jj = 0; jj < 8; ++jj) gq[jj] = *(const f32x4*)(g + 4 * C.lane + 256 * jj);
    u32x2 xr[4][8];
#pragma unroll
    for (int i = 0; i < 4; ++i)
#pragma unroll
        for (int jj = 0; jj < 8; ++jj) xr[i][jj] = *(const u32x2*)(X + (size_t)(C.rb + i * C.rs) * DM + 4 * C.lane + 256 * jj);
#pragma unroll
    for (int p = 0; p < 2; ++p) {
        __syncthreads();
#pragma unroll
        for (int i = 0; i < 4; ++i) {
            const int m = C.rb + (4 * p + i) * C.rs;
            float ss = 0.f;
#pragma unroll
            for (int jj = 0; jj < 8; ++jj) { const float a0 = lo16(xr[i][jj].x), a1 = hi16(xr[i][jj].x), a2 = lo16(xr[i][jj].y), a3 = hi16(xr[i][jj].y); ss += (a0 * a0 + a1 * a1) + (a2 * a2 + a3 * a3); }
            const float r = 1.0f / sqrtf(wave_sum(ss) * (1.0f / DM) + EPS);
#pragma unroll
            for (int jj = 0; jj < 8; ++jj) {
                const f32x4 a = (f32x4){lo16(xr[i][jj].x), hi16(xr[i][jj].x), lo16(xr[i][jj].y), hi16(xr[i][jj].y)} * r * gq[jj];
                *(unsigned*)(XN8 + (size_t)m * DM + 4 * C.lane + 256 * jj) = pk4_fp8(a.x * pg8::SC_X, a.y * pg8::SC_X, a.z * pg8::SC_X, a.w * pg8::SC_X);
                u32x2 o; o.x = pk2(a.x, a.y); o.y = pk2(a.z, a.w);
                *(LAS u32x2*)(T + (4 * C.wave + i) * RS + (4 * C.lane + 256 * jj) * 2) = o;
            }
        }
        if (p == 0) {
#pragma unroll
            for (int i = 0; i < 4; ++i)
#pragma unroll
                for (int jj = 0; jj < 8; ++jj) xr[i][jj] = *(const u32x2*)(X + (size_t)(C.rb + (4 + i) * C.rs) * DM + 4 * C.lane + 256 * jj);
        }
        LDS_WAIT(); __syncthreads();
        f32x4 acc0 = {0.f, 0.f, 0.f, 0.f}, acc1 = {0.f, 0.f, 0.f, 0.f};
#pragma unroll
        for (int s2 = 0; s2 < 8; ++s2) {
            const bf16x8 a0 = *(const LAS bf16x8*)(T + l15 * RS + (256 * C.wave + 32 * s2 + 8 * kq) * 2), a1 = *(const LAS bf16x8*)(T + (16 + l15) * RS + (256 * C.wave + 32 * s2 + 8 * kq) * 2);
            acc0 = __builtin_amdgcn_mfma_f32_16x16x32_bf16(a0, bhi[s2], acc0, 0, 0, 0); acc0 = __builtin_amdgcn_mfma_f32_16x16x32_bf16(a0, blo[s2], acc0, 0, 0, 0);
            acc1 = __builtin_amdgcn_mfma_f32_16x16x32_bf16(a1, bhi[s2], acc1, 0, 0, 0); acc1 = __builtin_amdgcn_mfma_f32_16x16x32_bf16(a1, blo[s2], acc1, 0, 0, 0);
        }
#pragma unroll
        for (int rg = 0; rg < 4; ++rg) { PART[(C.wave * 32 + 4 * kq + rg) * NE + l15] = acc0[rg]; PART[(C.wave * 32 + 16 + 4 * kq + rg) * NE + l15] = acc1[rg]; }
        LDS_WAIT(); __syncthreads();
        {   const int row = C.tid >> 4, e = C.tid & 15;
            float lg = 0.f;
#pragma unroll
            for (int w = 0; w < 8; ++w) lg += PART[(w * 32 + row) * NE + e];
            float mx = lg; mx = fmaxf(mx, __shfl_xor(mx, 1)); mx = fmaxf(mx, __shfl_xor(mx, 2)); mx = fmaxf(mx, __shfl_xor(mx, 4)); mx = fmaxf(mx, __shfl_xor(mx, 8));
            const float ex = __expf(lg - mx); float se = ex; se += __shfl_xor(se, 1); se += __shfl_xor(se, 2); se += __shfl_xor(se, 4); se += __shfl_xor(se, 8);
            const int m = (C.rb - C.wave) + (row >> 2) + (4 * p + (row & 3)) * C.rs;
            AFFT[((size_t)(m >> 11) * NE + e) * SEQ + (m & (SEQ - 1))] = ex / se; }
    }
}

__device__ __forceinline__ unsigned wave_cnt4(bool f0, bool f1, bool f2, bool f3) {
    return (unsigned)(__builtin_popcountll(__ballot(f0)) + __builtin_popcountll(__ballot(f1)) + __builtin_popcountll(__ballot(f2)) + __builtin_popcountll(__ballot(f3)));
}
__device__ __forceinline__ unsigned lanes_below(bool f) { const unsigned long long m = __ballot(f); return __builtin_amdgcn_mbcnt_hi((unsigned)(m >> 32), __builtin_amdgcn_mbcnt_lo((unsigned)m, 0u)); }
__device__ __forceinline__ void rank_phase(const Ctx& C) {
    LAS unsigned* CN = (LAS unsigned*)C.lds;
    const float* AFFT = WSP(float, WS_AFFT); int* IDX = WSP(int, WS_IDX); float* GATE = WSP(float, WS_IDX + 512 * 1024); int* SEL = WSP(int, WS_SEL);
    const int u0 = (C.G == 256) ? (((int)blockIdx.x >> 3) < NE ? ((int)blockIdx.x & 7) * NE + ((int)blockIdx.x >> 3) : NB * NE) : (int)blockIdx.x;
    for (int u = u0; u < NB * NE; u += C.G) {
        const int b = u >> 4, e = u & 15;
        __syncthreads();
        if (C.tid < 64) CN[C.tid] = 0u;
        const f32x4 av = ((const f32x4*)(AFFT + (size_t)(b * NE + e) * SEQ))[C.tid];
        const unsigned k0 = __float_as_uint(av.x), k1 = __float_as_uint(av.y), k2 = __float_as_uint(av.z), k3 = __float_as_uint(av.w);
        LDS_WAIT(); __syncthreads();
        unsigned T = 0u;
        for (int rd = 0; rd < 15; ++rd) {
            const int lo = 28 - 2 * rd;
            const unsigned c1 = T | (1u << lo), c2 = T | (2u << lo), c3 = T | (3u << lo);
            const unsigned w1 = wave_cnt4(k0 >= c1, k1 >= c1, k2 >= c1, k3 >= c1), w2 = wave_cnt4(k0 >= c2, k1 >= c2, k2 >= c2, k3 >= c2), w3 = wave_cnt4(k0 >= c3, k1 >= c3, k2 >= c3, k3 >= c3);
            if (C.lane < 3) __hip_atomic_fetch_add(CN + 3 * rd + C.lane, C.lane == 0 ? w1 : C.lane == 1 ? w2 : w3, __ATOMIC_RELAXED, __HIP_MEMORY_SCOPE_WORKGROUP);
            LDS_WAIT(); __syncthreads();
            const unsigned n1 = CN[3 * rd], n2 = CN[3 * rd + 1], n3 = CN[3 * rd + 2];
            T = (n3 >= (unsigned)CAP) ? c3 : (n2 >= (unsigned)CAP) ? c2 : (n1 >= (unsigned)CAP) ? c1 : T;
        }
        { const unsigned ws = wave_cnt4(k0 > T, k1 > T, k2 > T, k3 > T);
          if (C.lane == 0) __hip_atomic_fetch_add(CN + 45, ws, __ATOMIC_RELAXED, __HIP_MEMORY_SCOPE_WORKGROUP); }
        const bool q0 = k0 == T, q1 = k1 == T, q2 = k2 == T, q3 = k3 == T;
        const unsigned qpre = lanes_below(q0) + lanes_below(q1) + lanes_below(q2) + lanes_below(q3);
        { const unsigned wt = wave_cnt4(q0, q1, q2, q3); if (C.lane == 0) CN[48 + C.wave] = wt; }
        LDS_WAIT(); __syncthreads();
        const unsigned need = (unsigned)CAP - CN[45];
        unsigned qb = qpre;
#pragma unroll
        for (int w = 0; w < 8; ++w) qb += (w < C.wave) ? CN[48 + w] : 0u;
        const bool s0 = k0 > T || (q0 && qb < need);
        const bool s1 = k1 > T || (q1 && qb + (q0 ? 1u : 0u) < need);
        const bool s2 = k2 > T || (q2 && qb + (q0 ? 1u : 0u) + (q1 ? 1u : 0u) < need);
        const bool s3 = k3 > T || (q3 && qb + (q0 ? 1u : 0u) + (q1 ? 1u : 0u) + (q2 ? 1u : 0u) < need);
        const unsigned spre = lanes_below(s0) + lanes_below(s1) + lanes_below(s2) + lanes_below(s3);
        { const unsigned wt = wave_cnt4(s0, s1, s2, s3); if (C.lane == 0) CN[56 + C.wave] = wt; }
        LDS_WAIT(); __syncthreads();
        unsigned sb = spre;
#pragma unroll
        for (int w = 0; w < 8; ++w) sb += (w < C.wave) ? CN[56 + w] : 0u;
        const int t0 = 4 * C.tid, row0 = b * SEQ + t0, ob = (e * NB + b) * CAP;
        const unsigned p0 = sb, p1 = p0 + (s0 ? 1u : 0u), p2 = p1 + (s1 ? 1u : 0u), p3 = p2 + (s2 ? 1u : 0u);
        if (s0) { IDX[ob + p0] = row0;     GATE[ob + p0] = av.x; }
        if (s1) { IDX[ob + p1] = row0 + 1; GATE[ob + p1] = av.y; }
        if (s2) { IDX[ob + p2] = row0 + 2; GATE[ob + p2] = av.z; }
        if (s3) { IDX[ob + p3] = row0 + 3; GATE[ob + p3] = av.w; }
        SEL[(size_t)(row0 + 0) * NE + e] = s0 ? (int)p0 : -1; SEL[(size_t)(row0 + 1) * NE + e] = s1 ? (int)p1 : -1;
        SEL[(size_t)(row0 + 2) * NE + e] = s2 ? (int)p2 : -1; SEL[(size_t)(row0 + 3) * NE + e] = s3 ? (int)p3 : -1;
    }
}

template <bool FINAL>
__device__ __forceinline__ void combine_phase(const Ctx& C, bf16_t* X, const float* g, float* OUT) {
    const int* SEL = WSP(int, WS_SEL); const unsigned char* Y = WSP(unsigned char, WS_Y); unsigned char* XN = WSP(unsigned char, WS_XN8);
    int cc[2][2];
#pragma unroll
    for (int j = 0; j < 2; ++j) { const int q = C.lane + 64 * j; cc[j][0] = (q >> 4) * 256 + (q & 15) * 8; cc[j][1] = cc[j][0] + 128; }
    int svn = -1; u32x4 xn[2][2]; f32x4 gq[2][2][2];
#pragma unroll
    for (int j = 0; j < 2; ++j)
#pragma unroll
        for (int k = 0; k < 2; ++k) { gq[j][k][0] = *(const f32x4*)(g + cc[j][k]); gq[j][k][1] = *(const f32x4*)(g + cc[j][k] + 4); }
    if (C.rb < C.re) { svn = C.lane < NE ? SEL[(size_t)C.rb * NE + C.lane] : -1;
#pragma unroll
        for (int j = 0; j < 2; ++j)
#pragma unroll
            for (int k = 0; k < 2; ++k) xn[j][k] = *(const u32x4*)(X + (size_t)C.rb * DM + cc[j][k]); }
    for (int m = C.rb; m < C.re; m += C.rs) {
        const int sv = svn;
        unsigned long long mask = __ballot(sv >= 0);
        bf16_t* xr = X + (size_t)m * DM;
        f32x4 v[2][2][2];
#pragma unroll
        for (int j = 0; j < 2; ++j)
#pragma unroll
            for (int k = 0; k < 2; ++k) { const u32x4 y = xn[j][k];
                v[j][k][0] = (f32x4){lo16(y.x), hi16(y.x), lo16(y.y), hi16(y.y)}; v[j][k][1] = (f32x4){lo16(y.z), hi16(y.z), lo16(y.w), hi16(y.w)}; }
        { const int mn = (m + C.rs < C.re) ? m + C.rs : m;
          svn = C.lane < NE ? SEL[(size_t)mn * NE + C.lane] : -1;
#pragma unroll
          for (int j = 0; j < 2; ++j)
#pragma unroll
              for (int k = 0; k < 2; ++k) xn[j][k] = *(const u32x4*)(X + (size_t)mn * DM + cc[j][k]); }
        const int b = m >> 11;
        while (mask) {
            const int e = __builtin_ctzll(mask); mask &= mask - 1;
            const int slot = __builtin_amdgcn_readlane(sv, e);
            const unsigned char* yr = Y + (size_t)(e * ER + b * CAP + slot) * DM + 16 * C.lane;
#pragma unroll
            for (int j = 0; j < 2; ++j) { const u32x4 y = __builtin_nontemporal_load((const u32x4*)(yr + 1024 * j));
                v[j][0][0] += up4_fp8(y.x) * Y_INV; v[j][0][1] += up4_fp8(y.y) * Y_INV; v[j][1][0] += up4_fp8(y.z) * Y_INV; v[j][1][1] += up4_fp8(y.w) * Y_INV; }
        }
        float ss = 0.f;
#pragma unroll
        for (int j = 0; j < 2; ++j)
#pragma unroll
            for (int k = 0; k < 2; ++k)
#pragma unroll
                for (int q = 0; q < 2; ++q) ss += (v[j][k][q].x * v[j][k][q].x + v[j][k][q].y * v[j][k][q].y) + (v[j][k][q].z * v[j][k][q].z + v[j][k][q].w * v[j][k][q].w);
        const float r = 1.0f / sqrtf(wave_sum(ss) * (1.0f / DM) + EPS);
#pragma unroll
        for (int j = 0; j < 2; ++j)
#pragma unroll
            for (int k = 0; k < 2; ++k) {
                const f32x4 a = v[j][k][0] * r * gq[j][k][0], bb = v[j][k][1] * r * gq[j][k][1];
                if (FINAL) { float* orow = OUT + (size_t)m * DM + cc[j][k]; __builtin_nontemporal_store(a, (f32x4*)orow); __builtin_nontemporal_store(bb, (f32x4*)(orow + 4)); }
                else { u32x4 xo; xo.x = pk2(v[j][k][0].x, v[j][k][0].y); xo.y = pk2(v[j][k][0].z, v[j][k][0].w); xo.z = pk2(v[j][k][1].x, v[j][k][1].y); xo.w = pk2(v[j][k][1].z, v[j][k][1].w);
                    __builtin_nontemporal_store(xo, (u32x4*)(xr + cc[j][k]));
                    u32x2 o; o.x = pk4_fp8(a.x * 8.0f, a.y * 8.0f, a.z * 8.0f, a.w * 8.0f); o.y = pk4_fp8(bb.x * 8.0f, bb.y * 8.0f, bb.z * 8.0f, bb.w * 8.0f);
                    __builtin_nontemporal_store(o, (u32x2*)(XN + (size_t)m * DM + cc[j][k])); }
            }
    }
}

struct Args { const void* in[19]; float* out; unsigned char* ws; int ph_lo, ph_hi; };
constexpr int NPHASE = 18;

__global__ void __launch_bounds__(NTHR, 2) mk_fwd(Args args) {
    extern __shared__ __attribute__((aligned(16))) unsigned char lds_raw[];
    Ctx C;
    C.lds = (LAS unsigned char*)lds_raw;
    C.tid = threadIdx.x; C.lane = C.tid & 63; C.wave = __builtin_amdgcn_readfirstlane(C.tid >> 6);
    C.G = gridDim.x; C.gw = blockIdx.x * NWAVES + C.wave; C.NGW = C.G * NWAVES;
    if (C.G == 256) { const int v = (int)blockIdx.x & 7, lr = (int)blockIdx.x >> 3; C.rb = v * SEQ + lr * NWAVES + C.wave; C.rs = 32 * NWAVES; C.re = (v + 1) * SEQ; }
    else { C.rb = C.gw; C.rs = C.NGW; C.re = M; }
    C.ws = args.ws; C.ctl = (gu32*)(args.ws + WS_CTL);
#define INF(k) ((const float*)args.in[k])
    volatile LAS unsigned* MISC = (volatile LAS unsigned*)(C.lds + MISC_OFF);
    LAS int* tab = (LAS int*)(C.lds + TAB_OFF);
    for (int u = C.tid; u < 64; u += NTHR) ((LAS unsigned*)(C.lds + MISC_OFF))[u] = 0u;
    __syncthreads();
    XcdBarrier bar; bar.bar = (unsigned*)(C.ctl + CW_BAR); bar.x = 0; bar.st = nullptr;
#if !MK_PER_PHASE
    bar = xcd_barrier_post((unsigned*)(C.ctl + CW_BAR), MISC + 8);
#define GRID_BAR() xcd_barrier(bar)
#define LOCAL_BAR_A(ACQ) do { if (lok) { lgen += 32u; xcd_local_barrier(bar, lgen, ACQ); } else xcd_barrier(bar); } while (0)
#define LOCAL_BAR() LOCAL_BAR_A(false)
    if (C.tid == 0 && (xb_xcc_id() != (blockIdx.x & 7u) || gridDim.x != 256u)) atomicAdd(&bar.bar[XB_BAD], 1u);
#else
#define GRID_BAR() do {} while (0)
#define LOCAL_BAR_A(ACQ) do {} while (0)
#define LOCAL_BAR() do {} while (0)
#endif
    bool lok = false; unsigned lgen = 0u;
    const int lo = args.ph_lo, hi = args.ph_hi;
#ifndef PHASE_MASK
#define PHASE_MASK 0x3ffff
#endif
#define IN(k) (((PHASE_MASK >> (k)) & 1) && lo <= (k) && (k) < hi)
#ifndef REP_MASK
#define REP_MASK 0x0
#endif
#define REPS(k) for (int rep_ = 0; rep_ < (((REP_MASK >> (k)) & 1) ? 2 : 1); ++rep_)
#define SEAM(k) do { if (IN(k) && IN((k) + 1)) GRID_BAR(); } while (0)
#define SEAM_L(k) do { if (IN(k) && IN((k) + 1)) LOCAL_BAR(); } while (0)
    const int cidx = (int)blockIdx.x;
    const int uidx = (C.G == 256) ? (cidx & 7) * 32 + (cidx >> 3) : cidx;
    const unsigned char* XN8 = WSP(unsigned char, WS_XN8); bf16_t* PROJ = WSP(bf16_t, WS_PROJ); bf16_t* CAT = WSP(bf16_t, WS_CAT);
    bf16_t* X = WSP(bf16_t, WS_XB);

    if (IN(0)) REPS(0) { p0_prologue(C, INF(16), INF(17), INF(18), INF(7), INF(8), INF(11), INF(14), INF(12), INF(9), INF(0), INF(3), INF(1), INF(5), (const int*)args.in[2], INF(10), INF(15)); } SEAM(0);
#if !MK_PER_PHASE
    if (IN(0) && IN(1)) { if (C.tid == 0) MISC[24] = xb_ld(&bar.bar[XB_BAD]); __syncthreads(); lok = __builtin_amdgcn_readfirstlane((int)MISC[24]) == 0; }
#endif
    if (IN(1)) REPS(1) {
        const bool part = (C.G == 256); const int q8 = cidx >> 3;
        const bool conv = part && ((q8 & 3) == 3);
        const int ci = (q8 >> 2) * 8 + (cidx & 7), gi = ((q8 >> 2) * 3 + (q8 & 3)) * 8 + (cidx & 7);
        pg8::ProbDense p{WSP(bf16_t, WS_XN), WSP(bf16_t, WS_WPIN), PROJ, 64, 8, DM, WSP(bf16_t, WS_MEMN), WSP(bf16_t, WS_WMEMKV), WSP(bf16_t, WS_MEMKV), 8, 8, DM, 32, DM, DM, part ? 192 : C.G, part ? (conv ? -1 : gi) : cidx};
        pg8::gemm_phase(C.lds, tab, p);
        { pg8::ProbFold pf{WSP(bf16_t, WS_WPOUT), WSP(bf16_t, WS_WGRP), WSP(bf16_t, WS_WPOUT2), 6, DM, 384, C.G, part ? (conv ? ci : -1) : (C.G >= 128 ? cidx - 64 : cidx)}; pg8::gemm_phase(C.lds, tab, pf); }
        if (part) { if (conv) expert_slot(C, ci * CONV1_N, CONV1_N, INF(16), INF(17), INF(18)); }
        else expert_items(IT_EXP - IT_MOVED + C.gw, C.NGW, IT_EXP - IT_MOVED + SLOT1_ITEMS, INF(16), INF(17), INF(18), C.ws, C.lane);
    } SEAM(1);
    if (IN(2)) REPS(2) {
        down_items((C.G == 256 ? 2 * C.NGW : 0) + C.gw, C.NGW, NE * 512, INF(18), C.ws, C.lane);
        for (int u = uidx; u < 256; u += C.G) xattn_unit<false, 2>(C, u, PROJ, DM, TOK, 0, C.gw + C.NGW < NE * 512 ? C.gw : 0, C.gw + C.NGW < NE * 512 ? C.NGW : 0, INF(18));
        pool_phase(C);
    } do { if (IN(2) && IN(4)) LOCAL_BAR(); } while (0);
    if (IN(4)) REPS(4) { pg8::ProbOut<true> p{CAT, WSP(bf16_t, WS_WPOUT2), WSP(bf16_t, WS_XN), X, WSP(float, WS_RINV), INF(3), 32, DM, DM, C.G, cidx}; pg8::gemm_phase(C.lds, tab, p); } SEAM_L(4);
#define MOE_PHASES(layer, pb) do { \
        if (IN(pb)) REPS(pb) { if (C.G == 256) router_phase_mfma(C, X, INF(4) + (layer) * DM, WSP(bf16_t, WS_WRT) + (size_t)(layer) * 2 * NE * DM); else router_phase(C, X, INF(4) + (layer) * DM, INF(15) + (size_t)(layer) * DM * NE); } SEAM_L(pb); \
        if (IN((pb) + 1)) REPS((pb) + 1) { rank_phase(C); } SEAM((pb) + 1); \
        if (IN((pb) + 2)) REPS((pb) + 2) { pg8::ProbGU p{WSP(unsigned char, WS_XN8), WSP(unsigned char, WS_WGU) + (size_t)(layer) * NE * DM * DM, WSP(int, WS_IDX), WSP(bf16_t, WS_HACT), 16, DM, DM, C.G, cidx}; pg8::gemm_phase(C.lds, tab, p); } SEAM_L((pb) + 2); \
        if (IN((pb) + 3)) REPS((pb) + 3) { pg8::ProbDN p{WSP(bf16_t, WS_HACT), (const bf16_t*)(WSP(unsigned char, WS_WDN) + (size_t)(layer) * NE * DM * DE), WSP(float, WS_IDX + 512 * 1024), WSP(bf16_t, WS_Y), 8, DE, DE, C.G, cidx}; pg8::gemm_phase(C.lds, tab, p); } SEAM((pb) + 3); \
    } while (0)
    MOE_PHASES(0, 5);
    if (IN(9)) { combine_phase<false>(C, X, INF(3) + DM, args.out); } SEAM_L(9);
    if (IN(10)) REPS(10) {
        const bool part = (C.G == 256); const int q8 = cidx >> 3;
        const bool conv = part && (q8 & 7) >= 5;
        const int ci = ((q8 >> 3) * 3 + (q8 & 7) - 5) * 8 + (cidx & 7), gi = ((q8 >> 3) * 5 + (q8 & 7)) * 8 + (cidx & 7);
        pg8::ProbDense8 p{XN8, WSP(unsigned char, WS_WAIN), PROJ, 64, 10, AINP, nullptr, nullptr, nullptr, 0, 0, 0, 16, DM, DM, part ? 160 : C.G, part ? (conv ? -1 : gi) : cidx};
        pg8::gemm_phase(C.lds, tab, p);
        if (part) { if (conv) { expert_slot(C, SLOT1_ITEMS + ci * CONV2_N, CONV2_N, INF(16), INF(17), INF(18)); down_items(NE * 512 + ci * DN10_N + C.wave, NWAVES, NE * 512 + (ci + 1) * DN10_N, INF(18), C.ws, C.lane); } }
        else expert_items(IT_EXP - IT_MOVED + SLOT1_ITEMS + C.gw, C.NGW, IT_EXP, INF(16), INF(17), INF(18), C.ws, C.lane);
    } SEAM_L(10);
    if (IN(11)) REPS(11) {
        if (C.G != 256) down_items(NE * 512 + C.gw, C.NGW, 2 * NE * 512, INF(18), C.ws, C.lane);
#pragma unroll 1
        for (int k = 0; k < 3; ++k) { const int u = uidx * 3 + k; int di = NE * 512 + DN10_ITEMS + C.gw + k * C.NGW; if (C.G != 256 || di >= 2 * NE * 512) di = 2 * NE * 512 - 1 - C.wave;
            if (u < 768) wattn_unit(C, u, INF(13), di, INF(18)); }
        if (C.G < 256) for (int u = C.G * 3 + cidx; u < 768; u += C.G) wattn_unit(C, u, INF(13), 2 * NE * 512 - 1 - C.wave, INF(18));
        { Ctx C2 = C; asm volatile("" : "+v"(C2.tid), "+v"(C2.lane));
          int dx = NE * 512 + DN10_ITEMS + C.gw + 3 * C.NGW; if (C.G != 256 || dx >= 2 * NE * 512) dx = 2 * NE * 512 - 1 - C.wave;
          for (int u = uidx; u < 256; u += C.G) xattn_unit<true, 1>(C2, u, PROJ, AINP, TOK + 2 * KVW, 1024, dx, 0, INF(18)); }
    } SEAM_L(11);
    if (IN(12)) { pg8::ProbOut8 p{WSP(unsigned char, WS_CAT), WSP(unsigned char, WS_WAOUT), X, 16, DM, DM, C.G, cidx}; pg8::gemm_phase(C.lds, tab, p); } do { if (IN(12) && IN(13)) LOCAL_BAR_A(true); } while (0);
    MOE_PHASES(1, 13);
    if (IN(17)) { combine_phase<true>(C, X, INF(6), args.out); }
#undef IN
#undef SEAM
#undef SEAM_L
}

extern "C" void kernel_launch(void* const* d_in, const int* in_sizes, int n_in, void* d_out, int out_size, void* d_ws, size_t ws_size, hipStream_t stream) {
    static int grid = 0;
    if (grid == 0) {
        if (n_in != 19 || out_size != M * DM || ws_size < WS_END) { fprintf(stderr, "kernel_launch: unexpected shapes (n_in %d, out %d, ws %zu < %zu); nothing launched\n", n_in, out_size, ws_size, (size_t)WS_END); grid = -1; return; }
        int dev = 0, cus = 0, per_cu = 0;
        if (hipGetDevice(&dev) != hipSuccess || hipDeviceGetAttribute(&cus, hipDeviceAttributeMultiprocessorCount, dev) != hipSuccess) { fprintf(stderr, "kernel_launch: device query failed\n"); grid = -1; return; }
        if (hipFuncSetAttribute((const void*)mk_fwd, hipFuncAttributeMaxDynamicSharedMemorySize, LDS_BYTES) != hipSuccess) { fprintf(stderr, "kernel_launch: hipFuncSetAttribute failed\n"); grid = -1; return; }
        if (hipOccupancyMaxActiveBlocksPerMultiprocessor(&per_cu, (const void*)mk_fwd, NTHR, LDS_BYTES) != hipSuccess || per_cu < 1)
            fprintf(stderr, "kernel_launch: note: occupancy query reports %d workgroups per CU\n", per_cu);
        (void)hipGetLastError();
        grid = cus;
        if (grid != 256) fprintf(stderr, "kernel_launch: note: %d CUs (tuned for 256)\n", grid);
    }
    if (grid < 0) return;
    if (hipMemsetAsync((char*)d_ws + WS_CTL, 0, CTL_ZERO_BYTES, stream) != hipSuccess) { fprintf(stderr, "kernel_launch: hipMemsetAsync failed\n"); return; }
    Args a{};
    for (int i = 0; i < 19; ++i) a.in[i] = d_in[i];
    a.out = (float*)d_out; a.ws = (unsigned char*)d_ws;
#if MK_PER_PHASE
    for (int ph = 0; ph < NPHASE; ++ph) { a.ph_lo = ph; a.ph_hi = ph + 1; hipLaunchKernelGGL(mk_fwd, dim3(grid), dim3(NTHR), LDS_BYTES, stream, a); }
#else
    a.ph_lo = 0; a.ph_hi = NPHASE;
    hipLaunchKernelGGL(mk_fwd, dim3(grid), dim3(NTHR), LDS_BYTES, stream, a);
#endif
    const hipError_t le = hipPeekAtLastError();
    if (le != hipSuccess) fprintf(stderr, "kernel_launch: launch failed: %s\n", hipGetErrorName(le));
}
```
